# Optimizing an MI355X kernel written in HIP

```python
import math
import jax, jax.numpy as jnp
from jax import lax
import numpy as np


D_MODEL = 2048
BATCH = 1
SEQ = 8192
DEPTH = 1

CHUNK = 64
S5_WIDTH = 1024
S5_GROUP_WIDTH = 16
S5_GROUPS = S5_WIDTH // S5_GROUP_WIDTH
S5_STATE = 64
SGU_WIDTH = 1024
SGU_HEADS = 8
SGU_HEAD_DIM = SGU_WIDTH // SGU_HEADS
MLP_CHUNK = 128
MIX_IN = S5_WIDTH + 2 * SGU_WIDTH
D_FF = 5632
NORM_EPS = 1e-6
DT_MIN = 1e-3
DT_MAX = 1e-1

kernel_name = 'hybrid_s5_sgu_macaron_block'


def rms_norm(x, g):
    xf = x.astype(jnp.float32)
    y = xf * lax.rsqrt(jnp.mean(xf * xf, axis=-1, keepdims=True) + NORM_EPS)
    return (y * g.astype(jnp.float32)).astype(x.dtype)


def layer_norm(x, g, b):
    xf = x.astype(jnp.float32)
    mu = jnp.mean(xf, axis=-1, keepdims=True)
    var = jnp.mean(jnp.square(xf - mu), axis=-1, keepdims=True)
    y = (xf - mu) * lax.rsqrt(var + NORM_EPS)
    return (y * g.astype(jnp.float32) + b.astype(jnp.float32)).astype(x.dtype)


def swiglu_ffn(h, w_gate, w_up, w_down):
    return (jax.nn.silu(h @ w_gate) * (h @ w_up)) @ w_down


def _complex_affine_combine(e1, e2):
    a1r, a1i, b1r, b1i = e1
    a2r, a2i, b2r, b2i = e2
    ar = a2r * a1r - a2i * a1i
    ai = a2r * a1i + a2i * a1r
    br = a2r * b1r - a2i * b1i + b2r
    bi = a2r * b1i + a2i * b1r + b2i
    return (ar, ai, br, bi)


def s5_mixer(u, a_re, a_im, log_dt, b_re, b_im, c_re, c_im, d_skip, w_glu, b_glu):
    bsz, seq, _ = u.shape
    uf = u.astype(jnp.float32).reshape(bsz, seq, S5_GROUPS, S5_GROUP_WIDTH)
    lam_re = a_re.astype(jnp.float32)
    lam_im = a_im.astype(jnp.float32)
    dt = jnp.exp(log_dt.astype(jnp.float32))[:, None]
    decay = jnp.exp(lam_re * dt)
    abar_re = decay * jnp.cos(lam_im * dt)
    abar_im = decay * jnp.sin(lam_im * dt)
    denom = lam_re * lam_re + lam_im * lam_im
    num_re = abar_re - 1.0
    num_im = abar_im
    k_re = (num_re * lam_re + num_im * lam_im) / denom
    k_im = (num_im * lam_re - num_re * lam_im) / denom
    bu_re = jnp.einsum('blgc,gpc->blgp', uf, b_re.astype(jnp.float32))
    bu_im = jnp.einsum('blgc,gpc->blgp', uf, b_im.astype(jnp.float32))
    in_re = k_re * bu_re - k_im * bu_im
    in_im = k_re * bu_im + k_im * bu_re
    a_r = jnp.broadcast_to(abar_re, in_re.shape)
    a_i = jnp.broadcast_to(abar_im, in_re.shape)
    _, _, x_re, x_im = lax.associative_scan(
        _complex_affine_combine, (a_r, a_i, in_re, in_im), axis=1)
    y = (jnp.einsum('blgp,gcp->blgc', x_re, c_re.astype(jnp.float32))
         - jnp.einsum('blgp,gcp->blgc', x_im, c_im.astype(jnp.float32))
         + d_skip.astype(jnp.float32) * uf)
    y = jax.nn.gelu(y.reshape(bsz, seq, S5_WIDTH)).astype(u.dtype)
    return y * jax.nn.sigmoid(y @ w_glu + b_glu)


def sgu_mixer(uv, ln_g, ln_b, w_s, b_s):
    u, v = jnp.split(jax.nn.gelu(uv), 2, axis=-1)
    v = layer_norm(v, ln_g, ln_b)
    bsz, seq, _ = v.shape
    n_chunks = seq // MLP_CHUNK
    v = v.reshape(bsz, n_chunks, MLP_CHUNK, SGU_HEADS, SGU_HEAD_DIM)
    blk = jnp.arange(MLP_CHUNK) // CHUNK
    mask = blk[:, None] >= blk[None, :]
    ws = jnp.where(mask[None], w_s, jnp.zeros((), w_s.dtype))
    mixed = jnp.einsum('hts,bnshc->bnthc', ws, v) + jnp.transpose(b_s)[:, :, None]
    return u * mixed.reshape(bsz, seq, SGU_WIDTH)


def setup_inputs(seed: int = 0) -> dict:
    key = jax.random.key(seed)
    keys = iter(jax.random.split(key, 40))
    L = DEPTH
    D = D_MODEL

    def nrm(shape, scale):
        return scale * jax.random.normal(next(keys), shape, jnp.float32)

    x = nrm((BATCH, SEQ, D), 1.0)
    ffn1_norm = 1.0 + nrm((L, D), 0.02)
    ffn1_w_gate = nrm((L, D, D_FF), D ** -0.5)
    ffn1_w_up = nrm((L, D, D_FF), D ** -0.5)
    ffn1_w_down = nrm((L, D_FF, D), D_FF ** -0.5)
    mix_norm = 1.0 + nrm((L, D), 0.02)
    w_in = nrm((L, D, MIX_IN), D ** -0.5)
    n_idx = jnp.arange(S5_STATE, dtype=jnp.float32)
    s5_a_re = -0.5 + nrm((L, S5_GROUPS, S5_STATE), 0.01)
    s5_a_im = math.pi * n_idx + nrm((L, S5_GROUPS, S5_STATE), 0.01)
    s5_log_dt = math.log(DT_MIN) + jax.random.uniform(
        next(keys), (L, S5_GROUPS), jnp.float32) * (math.log(DT_MAX) - math.log(DT_MIN))
    s5_b_re = nrm((L, S5_GROUPS, S5_STATE, S5_GROUP_WIDTH), (2 * S5_GROUP_WIDTH) ** -0.5)
    s5_b_im = nrm((L, S5_GROUPS, S5_STATE, S5_GROUP_WIDTH), (2 * S5_GROUP_WIDTH) ** -0.5)
    s5_c_re = nrm((L, S5_GROUPS, S5_GROUP_WIDTH, S5_STATE), S5_STATE ** -0.5)
    s5_c_im = nrm((L, S5_GROUPS, S5_GROUP_WIDTH, S5_STATE), S5_STATE ** -0.5)
    s5_d = nrm((L, S5_GROUPS, S5_GROUP_WIDTH), 1.0)
    s5_w_glu = nrm((L, S5_WIDTH, S5_WIDTH), S5_WIDTH ** -0.5)
    s5_b_glu = nrm((L, S5_WIDTH), 0.01)
    sgu_ln_g = 1.0 + nrm((L, SGU_WIDTH), 0.02)
    sgu_ln_b = nrm((L, SGU_WIDTH), 0.01)
    sgu_w_s = nrm((L, SGU_HEADS, MLP_CHUNK, MLP_CHUNK), 0.05)
    sgu_b_s = 1.0 + nrm((L, SGU_HEADS, MLP_CHUNK), 0.05)
    w_branch_a = nrm((L, S5_WIDTH, D), S5_WIDTH ** -0.5)
    w_branch_b = nrm((L, SGU_WIDTH, D), SGU_WIDTH ** -0.5)
    w_gate = nrm((L, D, 2 * D), D ** -0.5)
    b_gate = nrm((L, 2 * D), 0.01)
    w_out = nrm((L, D, D), D ** -0.5)
    ffn2_norm = 1.0 + nrm((L, D), 0.02)
    ffn2_w_gate = nrm((L, D, D_FF), D ** -0.5)
    ffn2_w_up = nrm((L, D, D_FF), D ** -0.5)
    ffn2_w_down = nrm((L, D_FF, D), D_FF ** -0.5)
    final_norm = 1.0 + nrm((D,), 0.02)
    return {
        'x': x,
        'ffn1_norm': ffn1_norm, 'ffn1_w_gate': ffn1_w_gate, 'ffn1_w_up': ffn1_w_up,
        'ffn1_w_down': ffn1_w_down,
        'mix_norm': mix_norm, 'w_in': w_in,
        's5_a_re': s5_a_re, 's5_a_im': s5_a_im, 's5_log_dt': s5_log_dt,
        's5_b_re': s5_b_re, 's5_b_im': s5_b_im, 's5_c_re': s5_c_re, 's5_c_im': s5_c_im,
        's5_d': s5_d, 's5_w_glu': s5_w_glu, 's5_b_glu': s5_b_glu,
        'sgu_ln_g': sgu_ln_g, 'sgu_ln_b': sgu_ln_b, 'sgu_w_s': sgu_w_s, 'sgu_b_s': sgu_b_s,
        'w_branch_a': w_branch_a, 'w_branch_b': w_branch_b,
        'w_gate': w_gate, 'b_gate': b_gate, 'w_out': w_out,
        'ffn2_norm': ffn2_norm, 'ffn2_w_gate': ffn2_w_gate, 'ffn2_w_up': ffn2_w_up,
        'ffn2_w_down': ffn2_w_down,
        'final_norm': final_norm,
    }


def reference(x, ffn1_norm, ffn1_w_gate, ffn1_w_up, ffn1_w_down, mix_norm, w_in,
              s5_a_re, s5_a_im, s5_log_dt, s5_b_re, s5_b_im, s5_c_re, s5_c_im, s5_d,
              s5_w_glu, s5_b_glu, sgu_ln_g, sgu_ln_b, sgu_w_s, sgu_b_s,
              w_branch_a, w_branch_b, w_gate, b_gate, w_out,
              ffn2_norm, ffn2_w_gate, ffn2_w_up, ffn2_w_down, final_norm):
    for i in range(DEPTH):
        h = rms_norm(x, ffn1_norm[i])
        x = x + 0.5 * swiglu_ffn(h, ffn1_w_gate[i], ffn1_w_up[i], ffn1_w_down[i])
        h = rms_norm(x, mix_norm[i])
        proj = h @ w_in[i]
        u_a = proj[..., :S5_WIDTH]
        uv_b = proj[..., S5_WIDTH:]
        y_a = s5_mixer(u_a, s5_a_re[i], s5_a_im[i], s5_log_dt[i], s5_b_re[i], s5_b_im[i],
                       s5_c_re[i], s5_c_im[i], s5_d[i], s5_w_glu[i], s5_b_glu[i])
        y_b = sgu_mixer(uv_b, sgu_ln_g[i], sgu_ln_b[i], sgu_w_s[i], sgu_b_s[i])
        gates = jax.nn.sigmoid(h @ w_gate[i] + b_gate[i])
        g_a, g_b = jnp.split(gates, 2, axis=-1)
        merged = g_a * (y_a @ w_branch_a[i]) + g_b * (y_b @ w_branch_b[i])
        x = x + merged @ w_out[i]
        h = rms_norm(x, ffn2_norm[i])
        x = x + 0.5 * swiglu_ffn(h, ffn2_w_gate[i], ffn2_w_up[i], ffn2_w_down[i])
    return rms_norm(x, final_norm)
```

```cpp
#include <hip/hip_runtime.h>
#include <cstdio>
#include <cstdint>
#ifndef MK_N_LAUNCHES
#define MK_N_LAUNCHES 1
#endif
namespace pg8 {
#define PG8_LAS __attribute__((address_space(3)))
typedef unsigned short bf16_t;
typedef short bf16x8 __attribute__((ext_vector_type(8)));
typedef float f32x4 __attribute__((ext_vector_type(4)));
typedef unsigned u32x4 __attribute__((ext_vector_type(4)));
constexpr int BM = 256, BK = 64, HALF = 128, HTB = HALF * BK * 2  , STAGE_BYTES = 8 * HTB, NXCD = 8, WGM = 8;

__host__ __device__ __forceinline__ int lds_byte(int r, int c) { const int st = (r >> 4) * 2 + (c >> 5), rr = r & 15, cc = c & 31, ob = rr * 64 + cc * 2; return st * 1024 + (ob ^ (((ob >> 9) & 1) << 5)); }
__host__ __device__ __forceinline__ void stage_rc(int b, int& R, int& C) { const int st = b / 1024, sb = b % 1024, swz = sb ^ (((sb >> 9) & 1) << 5); R = (st >> 1) * 16 + swz / 64; C = (st & 1) * 32 + (swz % 64) / 2; }
__host__ __device__ __forceinline__ int perm32(int rho) { const int n = rho >> 4, i = rho & 15; return 8 * (i >> 2) + 4 * n + (i & 3); }

struct Unit { int pm, pn; };
struct Gemm { const bf16_t* A; const bf16_t* Bt; int M, N, K; };

struct StaticOrder {
    int nM, nN, nwg, G, c;
    __host__ __device__ void init(int M, int N, int G_, int c_) { nM = M / BM; nN = N / BM; nwg = nM * nN; G = G_; c = c_; }
    __host__ __device__ bool next(int i, Unit& u) const {
        const long L = (long)i * G + c; if (L >= nwg) return false;
        int wgid = (int)L; { const int q = nwg / NXCD, r = nwg % NXCD, xcd = wgid % NXCD, off = wgid / NXCD; wgid = (xcd < r ? xcd * (q + 1) : r * (q + 1) + (xcd - r) * q) + off; }
        const int nig = WGM * nN, gid = wgid / nig, fm = gid * WGM, gsz = (nM - fm) < WGM ? (nM - fm) : WGM;
        u.pm = fm + ((wgid % nig) % gsz); u.pn = (wgid % nig) / gsz; return true;
    }
    __device__ __forceinline__ void a_ready(const Unit&) const {}
    __device__ __forceinline__ void done(const Unit&) const {}
};

__device__ __forceinline__ unsigned cvt_pk_bf16(float lo, float hi) { unsigned r; asm volatile("v_cvt_pk_bf16_f32 %0, %1, %2" : "=v"(r) : "v"(lo), "v"(hi)); return r; }

typedef float f32x2 __attribute__((ext_vector_type(2)));
typedef unsigned u32x2 __attribute__((ext_vector_type(2)));
__device__ __forceinline__ float sigm(float x) { return __builtin_amdgcn_rcpf(1.0f + __builtin_amdgcn_exp2f(-1.4426950408889634f * x)); }
__device__ __forceinline__ float silu_f(float x) { return x * sigm(x); }
__device__ __forceinline__ float gelu_f(float x) { return x * sigm(1.5957691216057308f * (x + 0.044715f * x * x * x)); }
__device__ __forceinline__ float bf_lo(unsigned w) { return __uint_as_float(w << 16); }
__device__ __forceinline__ float bf_hi(unsigned w) { return __uint_as_float(w & 0xffff0000u); }
__device__ __forceinline__ u32x4 pack8(const f32x4 a, const f32x4 b) { u32x4 w; w.x = cvt_pk_bf16(a[0], a[1]); w.y = cvt_pk_bf16(a[2], a[3]); w.z = cvt_pk_bf16(b[0], b[1]); w.w = cvt_pk_bf16(b[2], b[3]); return w; }
__device__ __forceinline__ void unpack8(const u32x4 w, f32x4& a, f32x4& b) { a = (f32x4){bf_lo(w.x), bf_hi(w.x), bf_lo(w.y), bf_hi(w.y)}; b = (f32x4){bf_lo(w.z), bf_hi(w.z), bf_lo(w.w), bf_hi(w.w)}; }
constexpr float NORM_EPS = 1e-6f;
constexpr int DM = 2048;
template <int RMODE> __device__ __forceinline__ float row_rstd(const float* rs, int r, int fq) {
    if (RMODE == 0) return rs[r];
    const f32x4* p = (const f32x4*)(rs + (size_t)r * 32 + 8 * fq); const f32x4 a = p[0], b = p[1];
    float s = ((a[0] + a[1]) + (a[2] + a[3])) + ((b[0] + b[1]) + (b[2] + b[3]));
    s += __shfl_xor(s, 16); s += __shfl_xor(s, 32);
    return rsqrtf(s * (1.0f / DM) + NORM_EPS);
}
template <int RMODE> struct EpiFfnUp {
    static constexpr bool PERM = true, AFTER_DRAIN = false;
    bf16_t* act; int ldc; const float* rs;
    __device__ __forceinline__ void operator()(const f32x4 (&acc)[2][2][4][2], const Unit& u, int wr, int wc, int fr, int fq) const {
        asm volatile("" : "+v"(fr), "+v"(fq));
        const int row0 = u.pm * BM + wr * 64 + fr, col0 = u.pn * HALF + wc * 32 + 8 * fq;
#pragma unroll
        for (int ai = 0; ai < 2; ++ai)
#pragma unroll
            for (int m = 0; m < 4; ++m) { const int r = row0 + ai * HALF + m * 16; const float rstd = row_rstd<RMODE>(rs, r, fq);
                f32x4 o0, o1;
#pragma unroll
                for (int j = 0; j < 4; ++j) { o0[j] = silu_f(acc[ai][0][m][0][j] * rstd) * (acc[ai][1][m][0][j] * rstd); o1[j] = silu_f(acc[ai][0][m][1][j] * rstd) * (acc[ai][1][m][1][j] * rstd); }
                *(u32x4*)(act + (size_t)r * ldc + col0) = pack8(o0, o1); }
    }
};
template <bool WB16> struct EpiResid {
    static constexpr bool PERM = true, AFTER_DRAIN = false;
    const float* xold; float* xnew; bf16_t* xb; float* ss; float scale;
    __device__ __forceinline__ void operator()(const f32x4 (&acc)[2][2][4][2], const Unit& u, int wr, int wc, int fr, int fq) const {
        asm volatile("" : "+v"(fr), "+v"(fq));
        const int row0 = u.pm * BM + wr * 64 + fr, col0 = u.pn * BM + wc * 32 + 8 * fq;
#pragma unroll
        for (int ai = 0; ai < 2; ++ai)
#pragma unroll
            for (int m = 0; m < 4; ++m) { const int r = row0 + ai * HALF + m * 16; float q = 0.f;
#pragma unroll
                for (int bj = 0; bj < 2; ++bj) { const size_t off = (size_t)r * DM + col0 + bj * HALF;
                    const f32x4 v0 = *(const f32x4*)(xold + off) + acc[ai][bj][m][0] * scale, v1 = *(const f32x4*)(xold + off + 4) + acc[ai][bj][m][1] * scale;
                    *(f32x4*)(xnew + off) = v0; *(f32x4*)(xnew + off + 4) = v1;
                    q += ((v0[0] * v0[0] + v0[1] * v0[1]) + (v0[2] * v0[2] + v0[3] * v0[3])) + ((v1[0] * v1[0] + v1[1] * v1[1]) + (v1[2] * v1[2] + v1[3] * v1[3]));
                    if (WB16) *(u32x4*)(xb + off) = pack8(v0, v1); }
                q += __shfl_xor(q, 16); q += __shfl_xor(q, 32);
                if (fq == 0) ss[(size_t)r * 32 + u.pn * 4 + wc] = q; }
    }
};
struct EpiMixIn {
    static constexpr bool PERM = true, AFTER_DRAIN = false;
    bf16_t *ua, *ub, *vb, *gt; float* lnst; const float* rs; const float* bgate;
    __device__ __forceinline__ void operator()(const f32x4 (&acc)[2][2][4][2], const Unit& u, int wr, int wc, int fr, int fq) const {
        asm volatile("" : "+v"(fr), "+v"(fq));
        const int row0 = u.pm * BM + wr * 64 + fr, colw = wc * 32 + 8 * fq;
        const int kind = u.pn < 4 ? 0 : (u.pn < 8 ? 1 : (u.pn < 12 ? 2 : 3));
#pragma unroll
        for (int ai = 0; ai < 2; ++ai)
#pragma unroll
            for (int m = 0; m < 4; ++m) { const int r = row0 + ai * HALF + m * 16; const float rstd = row_rstd<1>(rs, r, fq);
                if (kind == 0) {
#pragma unroll
                    for (int bj = 0; bj < 2; ++bj) { const int c = u.pn * BM + bj * HALF + colw;
                        *(u32x4*)(ua + ((size_t)(c >> 4) * 8192 + r) * 16 + (c & 15)) = pack8(acc[ai][bj][m][0] * rstd, acc[ai][bj][m][1] * rstd); }
                } else if (kind == 1) {
#pragma unroll
                    for (int bj = 0; bj < 2; ++bj) { const int c = (u.pn - 4) * BM + bj * HALF + colw; f32x4 o0, o1;
#pragma unroll
                        for (int j = 0; j < 4; ++j) { o0[j] = gelu_f(acc[ai][bj][m][0][j] * rstd); o1[j] = gelu_f(acc[ai][bj][m][1][j] * rstd); }
                        *(u32x4*)(ub + (size_t)r * 1024 + c) = pack8(o0, o1); }
                } else if (kind == 2) { float s1 = 0.f, s2 = 0.f;
#pragma unroll
                    for (int bj = 0; bj < 2; ++bj) { const int c = (u.pn - 8) * BM + bj * HALF + colw; f32x4 o0, o1;
#pragma unroll
                        for (int j = 0; j < 4; ++j) { o0[j] = gelu_f(acc[ai][bj][m][0][j] * rstd); o1[j] = gelu_f(acc[ai][bj][m][1][j] * rstd); s1 += o0[j] + o1[j]; s2 += o0[j] * o0[j] + o1[j] * o1[j]; }
                        *(u32x4*)(vb + (size_t)r * 1024 + c) = pack8(o0, o1); }
                    s1 += __shfl_xor(s1, 16); s1 += __shfl_xor(s1, 32); s2 += __shfl_xor(s2, 16); s2 += __shfl_xor(s2, 32);
                    if (fq == 0) *(f32x2*)(lnst + ((size_t)r * 16 + (u.pn - 8) * 4 + wc) * 2) = (f32x2){s1, s2};
                } else {
#pragma unroll
                    for (int bj = 0; bj < 2; ++bj) { const int c = (u.pn - 12) * BM + bj * HALF + colw; const f32x4 b0 = *(const f32x4*)(bgate + c), b1 = *(const f32x4*)(bgate + c + 4); f32x4 o0, o1;
#pragma unroll
                        for (int j = 0; j < 4; ++j) { o0[j] = sigm(acc[ai][bj][m][0][j] * rstd + b0[j]); o1[j] = sigm(acc[ai][bj][m][1][j] * rstd + b1[j]); }
                        *(u32x4*)(gt + (size_t)r * 4096 + c) = pack8(o0, o1); }
                } }
    }
};
struct EpiS5Loc {
    static constexpr bool PERM = true, AFTER_DRAIN = false;
    float* yloc; float* est;
    __device__ __forceinline__ void operator()(const f32x4 (&acc)[2][2][4][2], const Unit& u, int wr, int wc, int fr, int fq) const {
        asm volatile("" : "+v"(fr), "+v"(fq));
        const int g = u.pn / 3, j3 = u.pn - 3 * g, row0 = wr * 64 + fr, colw = wc * 32 + 8 * fq;
#pragma unroll
        for (int ai = 0; ai < 2; ++ai)
#pragma unroll
            for (int m = 0; m < 4; ++m) { const int n = row0 + ai * HALF + m * 16;
                if (j3 < 2) {
#pragma unroll
                    for (int bj = 0; bj < 2; ++bj) { float* p = yloc + ((size_t)g * 256 + n) * 512 + j3 * BM + bj * HALF + colw; *(f32x4*)p = acc[ai][bj][m][0]; *(f32x4*)(p + 4) = acc[ai][bj][m][1]; }
                } else { float* p = est + ((size_t)g * 256 + n) * 128 + colw; *(f32x4*)p = acc[ai][0][m][0]; *(f32x4*)(p + 4) = acc[ai][0][m][1]; } }
    }
};
struct EpiS5Out {
    static constexpr bool PERM = true, AFTER_DRAIN = false;
    const float* yloc; bf16_t* yg;
    __device__ __forceinline__ void operator()(const f32x4 (&acc)[2][2][4][2], const Unit& u, int wr, int wc, int fr, int fq) const {
        asm volatile("" : "+v"(fr), "+v"(fq));
        const int g = u.pn >> 1, j2 = u.pn & 1, row0 = wr * 64 + fr, colw = wc * 32 + 8 * fq;
#pragma unroll
        for (int ai = 0; ai < 2; ++ai)
#pragma unroll
            for (int m = 0; m < 4; ++m) { const int n = row0 + ai * HALF + m * 16;
#pragma unroll
                for (int bj = 0; bj < 2; ++bj) { const int col = j2 * BM + bj * HALF + colw; const float* p = yloc + ((size_t)g * 256 + n) * 512 + col;
                    const f32x4 y0 = *(const f32x4*)p + acc[ai][bj][m][0], y1 = *(const f32x4*)(p + 4) + acc[ai][bj][m][1]; f32x4 o0, o1;
#pragma unroll
                    for (int j = 0; j < 4; ++j) { o0[j] = gelu_f(y0[j]); o1[j] = gelu_f(y1[j]); }
                    *(u32x4*)(yg + ((size_t)(32 * n + (col >> 4))) * 1024 + 16 * g + (col & 15)) = pack8(o0, o1); } }
    }
};
struct EpiGlu {
    static constexpr bool PERM = true, AFTER_DRAIN = false;
    const bf16_t* yg; bf16_t* ya; const float* bglu;
    __device__ __forceinline__ void operator()(const f32x4 (&acc)[2][2][4][2], const Unit& u, int wr, int wc, int fr, int fq) const {
        asm volatile("" : "+v"(fr), "+v"(fq));
        const int row0 = u.pm * BM + wr * 64 + fr, col0 = u.pn * BM + wc * 32 + 8 * fq;
#pragma unroll
        for (int ai = 0; ai < 2; ++ai)
#pragma unroll
            for (int m = 0; m < 4; ++m) { const int r = row0 + ai * HALF + m * 16;
#pragma unroll
                for (int bj = 0; bj < 2; ++bj) { const int c = col0 + bj * HALF; const f32x4 b0 = *(const f32x4*)(bglu + c), b1 = *(const f32x4*)(bglu + c + 4);
                    f32x4 y0, y1; unpack8(*(const u32x4*)(yg + (size_t)r * 1024 + c), y0, y1); f32x4 o0, o1;
#pragma unroll
                    for (int j = 0; j < 4; ++j) { o0[j] = y0[j] * sigm(acc[ai][bj][m][0][j] + b0[j]); o1[j] = y1[j] * sigm(acc[ai][bj][m][1][j] + b1[j]); }
                    *(u32x4*)(ya + (size_t)r * 1024 + c) = pack8(o0, o1); } }
    }
};
template <bool SECOND> struct EpiBranch {
    static constexpr bool PERM = true, AFTER_DRAIN = false;
    const bf16_t* gt; bf16_t* mg;
    __device__ __forceinline__ void operator()(const f32x4 (&acc)[2][2][4][2], const Unit& u, int wr, int wc, int fr, int fq) const {
        asm volatile("" : "+v"(fr), "+v"(fq));
        const int row0 = u.pm * BM + wr * 64 + fr, col0 = u.pn * BM + wc * 32 + 8 * fq;
#pragma unroll
        for (int ai = 0; ai < 2; ++ai)
#pragma unroll
            for (int m = 0; m < 4; ++m) { const int r = row0 + ai * HALF + m * 16;
#pragma unroll
                for (int bj = 0; bj < 2; ++bj) { const int c = col0 + bj * HALF; f32x4 g0, g1; unpack8(*(const u32x4*)(gt + (size_t)r * 4096 + c), g0, g1);
                    f32x4 o0 = g0 * acc[ai][bj][m][0], o1 = g1 * acc[ai][bj][m][1];
                    if (SECOND) { f32x4 p0, p1; unpack8(*(const u32x4*)(mg + (size_t)r * DM + c), p0, p1); o0 += p0; o1 += p1; }
                    *(u32x4*)(mg + (size_t)r * DM + c) = pack8(o0, o1); } }
    }
};
struct BatchOrder {
    int nunits, NJ, G, c; bool AL;
    __device__ __forceinline__ bool next(int i, Unit& u) const { const int L = i * G + c; if (L >= nunits) return false; u.pm = AL ? L : L / NJ; u.pn = L; return true; }
    __device__ __forceinline__ void a_ready(const Unit&) const {}
    __device__ __forceinline__ void done(const Unit&) const {}
};

template <class Epi, class Sched, bool ALIGN_EPI = false, bool SP2 = false>
__device__ __forceinline__ void gemm_phase(PG8_LAS unsigned char* lds, const Gemm g, const Sched& S, const Epi& E) {
    const int tid = threadIdx.x, wid = __builtin_amdgcn_readfirstlane(tid >> 6), lane = tid & 63, wr = wid >> 2, wc = wid & 3, fr = lane & 15, fq = lane >> 4;
    const int K = g.K, nt = K / BK;
    unsigned voffA[2], voffB[2];
#pragma unroll
    for (int i = 0; i < 2; ++i) { int R, C; stage_rc(tid * 16 + i * 8192, R, C); const int Rb = Epi::PERM ? ((R & ~31) + perm32(R & 31)) : R;
        voffA[i] = (unsigned)(R * K + C) * 2u; voffB[i] = (unsigned)(Rb * K + C) * 2u; }
    const size_t kstep = (size_t)(BK * 2);
    const size_t hstep = (size_t)HALF * K * 2;
    const size_t tstep = 2 * hstep;
    const unsigned ldsw = (unsigned)wid * 1024u;
    const int aoff = lds_byte(wr * 64 + fr, fq * 8), boff = lds_byte(wc * 32 + fr, fq * 8);
#define PG8_SA(b, h) (((b) * 2 + (h)) * HTB)
#define PG8_SB(b, h) ((4 + (b) * 2 + (h)) * HTB)
#define PG8_STAGE(bufoff, gbase, voff) do { _Pragma("unroll") for (int _i = 0; _i < 2; ++_i) \
        __builtin_amdgcn_global_load_lds((const unsigned*)((const char*)(gbase) + (voff)[_i]), (PG8_LAS unsigned*)(lds + (bufoff) + ldsw + _i * 8192), 16, 0, 0); } while (0)
#define PG8_LDA(dst, b, h) do { _Pragma("unroll") for (int m = 0; m < 4; ++m) _Pragma("unroll") for (int k = 0; k < 2; ++k) dst[m][k] = *(const PG8_LAS bf16x8*)(lds + PG8_SA(b, h) + aoff + m * 2048 + k * 1024); } while (0)
#define PG8_LDB(dst, b, h) do { _Pragma("unroll") for (int n = 0; n < 2; ++n) _Pragma("unroll") for (int k = 0; k < 2; ++k) dst[n][k] = *(const PG8_LAS bf16x8*)(lds + PG8_SB(b, h) + boff + n * 2048 + k * 1024); } while (0)
#define PG8_MMA(ai, bj, At, Bt) do { __builtin_amdgcn_s_setprio(1); _Pragma("unroll") for (int m = 0; m < 4; ++m) _Pragma("unroll") for (int n = 0; n < 2; ++n) _Pragma("unroll") for (int k = 0; k < 2; ++k) \
        acc[ai][bj][m][n] = __builtin_amdgcn_mfma_f32_16x16x32_bf16(Bt[n][k], At[m][k], acc[ai][bj][m][n], 0, 0, 0); __builtin_amdgcn_s_setprio(0); } while (0)
#define PG8_WAIT_V(n) asm volatile("s_waitcnt vmcnt(" #n ")" ::: "memory")
#define PG8_WAIT_L(n) asm volatile("s_waitcnt lgkmcnt(" #n ")" ::: "memory")
#define PG8_BAR __builtin_amdgcn_s_barrier()
#define PG8_SCHED __builtin_amdgcn_sched_barrier(0)
    Unit cur, nxt; int ui = 0;
    if (!S.next(0, cur)) return;
    f32x4 acc[2][2][4][2];
#pragma unroll
    for (int a = 0; a < 2; ++a)
#pragma unroll
        for (int b = 0; b < 2; ++b)
#pragma unroll
            for (int m = 0; m < 4; ++m)
#pragma unroll
                for (int n = 0; n < 2; ++n) acc[a][b][m][n] = (f32x4){0.f, 0.f, 0.f, 0.f};
    bf16x8 At[4][2], B0[2][2], B1[2][2];
    const char* cA = (const char*)g.A + (size_t)cur.pm * tstep; const char* cB = (const char*)g.Bt + (size_t)cur.pn * tstep;
    S.a_ready(cur);
    if constexpr (SP2) {
        PG8_STAGE(PG8_SB(0, 0), cB, voffB); PG8_STAGE(PG8_SB(0, 1), cB + hstep, voffB); PG8_STAGE(PG8_SA(0, 0), cA, voffA); PG8_STAGE(PG8_SA(0, 1), cA + hstep, voffA);
        if (wr == 1) PG8_BAR;
        PG8_WAIT_V(2); PG8_BAR;
        PG8_STAGE(PG8_SB(1, 0), cB + kstep, voffB); PG8_STAGE(PG8_SA(1, 0), cA + kstep, voffA); PG8_STAGE(PG8_SB(1, 1), cB + hstep + kstep, voffB);
        PG8_WAIT_V(6); PG8_BAR;
    } else {
        PG8_STAGE(PG8_SB(0, 0), cB, voffB); PG8_STAGE(PG8_SA(0, 0), cA, voffA); PG8_STAGE(PG8_SB(0, 1), cB + hstep, voffB); PG8_STAGE(PG8_SA(0, 1), cA + hstep, voffA);
        if (wr == 1) PG8_BAR;
        PG8_WAIT_V(4); PG8_BAR;
        PG8_STAGE(PG8_SB(1, 0), cB + kstep, voffB); PG8_STAGE(PG8_SA(1, 0), cA + kstep, voffA); PG8_STAGE(PG8_SB(1, 1), cB + hstep + kstep, voffB);
        PG8_WAIT_V(6); PG8_BAR;
    }
    for (;;) {
        const bool has_next = S.next(ui + 1, nxt);
        const char* nA = has_next ? (const char*)g.A + (size_t)nxt.pm * tstep : cA; const char* nB = has_next ? (const char*)g.Bt + (size_t)nxt.pn * tstep : cB;
#pragma nounroll
        for (int t = 0; t < nt; t += 2) {
            const bool last = (t == nt - 2);
            const char* a1 = cA + (size_t)(t + 1) * kstep;
            const char* a2 = last ? nA : cA + (size_t)(t + 2) * kstep; const char* b2 = last ? nB : cB + (size_t)(t + 2) * kstep;
            const char* a3 = a2 + kstep; const char* b3 = b2 + kstep;
            if (last && has_next) S.a_ready(nxt);
            if constexpr (SP2) {
            PG8_LDB(B0, 0, 0); PG8_LDB(B1, 0, 1); PG8_SCHED; PG8_LDA(At, 0, 0); PG8_STAGE(PG8_SA(1, 1), a1 + hstep, voffA);
            PG8_WAIT_V(8); PG8_WAIT_L(0); PG8_BAR; PG8_MMA(0, 0, At, B0); PG8_MMA(0, 1, At, B1); PG8_BAR; PG8_SCHED;
            PG8_LDA(At, 0, 1); PG8_STAGE(PG8_SB(0, 0), b2, voffB); PG8_STAGE(PG8_SB(0, 1), b2 + hstep, voffB); PG8_STAGE(PG8_SA(0, 0), a2, voffA);
            PG8_WAIT_V(8); PG8_WAIT_L(0); PG8_BAR; PG8_MMA(1, 0, At, B0); PG8_MMA(1, 1, At, B1); PG8_BAR; PG8_SCHED;
            PG8_LDB(B0, 1, 0); PG8_LDB(B1, 1, 1); PG8_SCHED; PG8_LDA(At, 1, 0); PG8_STAGE(PG8_SA(0, 1), a2 + hstep, voffA);
            PG8_WAIT_V(8); PG8_WAIT_L(0); PG8_BAR; PG8_MMA(0, 0, At, B0); PG8_MMA(0, 1, At, B1); PG8_BAR; PG8_SCHED;
            PG8_LDA(At, 1, 1); PG8_STAGE(PG8_SB(1, 0), b3, voffB); PG8_STAGE(PG8_SB(1, 1), b3 + hstep, voffB); PG8_STAGE(PG8_SA(1, 0), a3, voffA);
            PG8_WAIT_V(8); PG8_WAIT_L(0); PG8_BAR; PG8_MMA(1, 0, At, B0); PG8_MMA(1, 1, At, B1); PG8_BAR; PG8_SCHED;
            } else {
            PG8_LDB(B0, 0, 0); PG8_SCHED; PG8_LDA(At, 0, 0); PG8_STAGE(PG8_SA(1, 1), a1 + hstep, voffA);
            PG8_WAIT_L(8); PG8_BAR; PG8_WAIT_L(0); PG8_MMA(0, 0, At, B0); PG8_BAR; PG8_SCHED;
            PG8_LDB(B1, 0, 1); PG8_STAGE(PG8_SB(0, 0), b2, voffB);
            PG8_BAR; PG8_WAIT_L(0); PG8_MMA(0, 1, At, B1); PG8_BAR;
            PG8_LDA(At, 0, 1); PG8_STAGE(PG8_SA(0, 0), a2, voffA);
            PG8_BAR; PG8_WAIT_L(0); PG8_MMA(1, 0, At, B0); PG8_BAR; PG8_SCHED;
            PG8_STAGE(PG8_SB(0, 1), b2 + hstep, voffB);
            PG8_WAIT_V(6); PG8_BAR; PG8_MMA(1, 1, At, B1); PG8_BAR;
            PG8_LDB(B0, 1, 0); PG8_SCHED; PG8_LDA(At, 1, 0); PG8_STAGE(PG8_SA(0, 1), a2 + hstep, voffA);
            PG8_WAIT_L(8); PG8_BAR; PG8_WAIT_L(0); PG8_MMA(0, 0, At, B0); PG8_BAR; PG8_SCHED;
            PG8_LDB(B1, 1, 1); PG8_STAGE(PG8_SB(1, 0), b3, voffB);
            PG8_BAR; PG8_WAIT_L(0); PG8_MMA(0, 1, At, B1); PG8_BAR;
            PG8_LDA(At, 1, 1); PG8_STAGE(PG8_SA(1, 0), a3, voffA);
            PG8_BAR; PG8_WAIT_L(0); PG8_MMA(1, 0, At, B0); PG8_BAR; PG8_SCHED;
            PG8_STAGE(PG8_SB(1, 1), b3 + hstep, voffB);
            PG8_WAIT_V(6); PG8_BAR; PG8_MMA(1, 1, At, B1); PG8_BAR;
            }
        }
        if constexpr (ALIGN_EPI) { if (wr == 0) PG8_BAR; }
        if constexpr (!Epi::AFTER_DRAIN) { E(acc, cur, wr, wc, fr, fq); S.done(cur); }
        if (!has_next) break;
#pragma unroll
        for (int a = 0; a < 2; ++a)
#pragma unroll
            for (int b = 0; b < 2; ++b)
#pragma unroll
                for (int m = 0; m < 4; ++m)
#pragma unroll
                    for (int n = 0; n < 2; ++n) acc[a][b][m][n] = (f32x4){0.f, 0.f, 0.f, 0.f};
        cur = nxt; cA = nA; cB = nB; ++ui;
        if constexpr (ALIGN_EPI) { if (wr == 1) PG8_BAR; }
    }
    PG8_WAIT_V(0);
    if constexpr (!ALIGN_EPI) { if (wr == 0) PG8_BAR; }
    PG8_BAR;
    if constexpr (Epi::AFTER_DRAIN) { E.fused(acc, cur, wr, wc, fr, fq, lds, wid, lane); S.done(cur); }
#undef PG8_SA
#undef PG8_SB
#undef PG8_STAGE
#undef PG8_LDA
#undef PG8_LDB
#undef PG8_MMA
#undef PG8_WAIT_V
#undef PG8_WAIT_L
#undef PG8_BAR
#undef PG8_SCHED
}
}

constexpr int NWAVES = 8;
constexpr int N_LAUNCHES = MK_N_LAUNCHES;
constexpr int PER_PHASE = 12;
constexpr int M = 8192, D = 2048, FF = 5632, NMIX = 7168, SW = 1024;
constexpr int S5G = 64, S5P = 64, S5C = 16, LC = 32, NCH = M / LC;
constexpr size_t MiB = 1u << 20;
constexpr size_t WS_CTL = 0, CTL_ZERO_BYTES = 65536;
constexpr size_t WS_SMALL = 1 * MiB;
constexpr size_t SM_RSTD0 = 0, SM_A32 = 65536, SM_A1024 = 131072, SM_WSB = 262144;
constexpr size_t WS_SS = 2 * MiB, WS_LNST = 3 * MiB;
constexpr size_t WS_W1A = 4 * MiB, WS_W2A = 48 * MiB, WS_WMIX = 70 * MiB, WS_WGLU = 98 * MiB, WS_WA = 100 * MiB, WS_WB = 104 * MiB, WS_WOUT = 108 * MiB;
constexpr size_t WS_XB = 116 * MiB, WS_YLOC = WS_XB;
constexpr size_t WS_ACT = 148 * MiB;
constexpr size_t WS_GT = WS_ACT, WS_UB = 212 * MiB, WS_EST = 228 * MiB;
constexpr size_t WS_UA = 236 * MiB, WS_YA = WS_UA, WS_VB = 252 * MiB, WS_YB = 268 * MiB, WS_YG = 284 * MiB, WS_XIN = 300 * MiB, WS_GM = 316 * MiB;
constexpr size_t WS_W1B = 236 * MiB, WS_W2B = 280 * MiB;
constexpr size_t WS_TM = 332 * MiB, WS_MG = WS_TM, WS_END = 380 * MiB;
static_assert(WS_W1A + (size_t)2 * FF * D * 2 <= WS_W2A && WS_W2A + (size_t)D * FF * 2 <= WS_WMIX && WS_WMIX + (size_t)NMIX * D * 2 <= WS_WGLU, "ws map 1");
static_assert(WS_XB + (size_t)M * D * 2 <= WS_ACT && WS_YLOC + (size_t)S5G * NCH * 512 * 4 <= WS_ACT && WS_ACT + (size_t)M * FF * 2 <= WS_UA, "ws map 2");
static_assert(WS_GT + (size_t)M * 4096 * 2 <= WS_UB && WS_EST + (size_t)S5G * NCH * 128 * 4 <= WS_UA && WS_XIN + (size_t)128 * 256 * 256 * 2 <= WS_GM && WS_GM + (size_t)S5G * 512 * 256 * 2 <= WS_TM, "ws map 3");
static_assert(WS_W1B + (size_t)2 * FF * D * 2 <= WS_W2B && WS_W2B + (size_t)D * FF * 2 <= WS_GM && WS_TM + (size_t)S5G * 768 * 512 * 2 <= WS_END && WS_MG + (size_t)M * D * 2 <= WS_END, "ws map 4");
constexpr int CW_BAR = 4096;
constexpr int RING_OFF = 0, RING_BYTES = 131072, LDSCTL_OFF = RING_BYTES, MISC_OFF = LDSCTL_OFF + 320, LDS_BYTES = 147456;

#define GAS __attribute__((address_space(1)))
#define LAS __attribute__((address_space(3)))
typedef unsigned short bf16;
typedef unsigned v4u __attribute__((ext_vector_type(4)));
typedef float f32x4 __attribute__((ext_vector_type(4)));
typedef float f32x2 __attribute__((ext_vector_type(2)));
typedef short bf16x8 __attribute__((ext_vector_type(8)));
typedef GAS unsigned gu32;
#define RLX_AGENT __ATOMIC_RELAXED, __HIP_MEMORY_SCOPE_AGENT
using pg8::NORM_EPS;
#define LDS_WAIT() asm volatile("s_waitcnt lgkmcnt(0)" ::: "memory")
#define VM_WAIT() asm volatile("s_waitcnt vmcnt(0)" ::: "memory")
__device__ __forceinline__ unsigned f2bf(float f) { unsigned u = __builtin_bit_cast(unsigned, f); return (u + 0x7fffu + ((u >> 16) & 1u)) >> 16; }
__device__ __forceinline__ unsigned pk2(float lo, float hi) { return f2bf(lo) | (f2bf(hi) << 16); }

#define XB_TMO      128
#define XB_XCNT(j)  (256  + 64 * (j))
#define XB_XSUB(j)  (1280 + 64 * (j))
#define XB_XGEN(j)  (2304 + 64 * (j))
#define XB_TOP      3328
#define XB_TOPGEN   3392
#define XCD_BAR_WORDS 3456
#define XB_SPIN_CAP (1u << 18)

__device__ __forceinline__ unsigned xb_ld(unsigned* p)              { return __hip_atomic_load(p, __ATOMIC_RELAXED, __HIP_MEMORY_SCOPE_AGENT); }
__device__ __forceinline__ unsigned xb_add(unsigned* p, unsigned v) { return __hip_atomic_fetch_add(p, v, __ATOMIC_RELAXED, __HIP_MEMORY_SCOPE_AGENT); }
__device__ __forceinline__ unsigned xb_xcc_id() { return (unsigned)__builtin_amdgcn_s_getreg((3 << 11) | 20) & 0xFu; }
#define XB_SPIN(cond, bar) do { unsigned _sp = 0; while (cond) { __builtin_amdgcn_s_sleep(1); \
    if ((++_sp & 255u) == 0u) { if (xb_ld(&(bar)[XB_TMO])) break; if (_sp > XB_SPIN_CAP) { atomicAdd(&(bar)[XB_TMO], 1u); break; } } } } while (0)

struct XcdBarrier {
    unsigned* bar; unsigned x;
    volatile LAS unsigned* st;
};

__device__ __forceinline__ XcdBarrier xcd_barrier_post(unsigned* bar, volatile LAS unsigned* st) {
    XcdBarrier b; b.bar = bar; b.x = xb_xcc_id(); b.st = st;
    if (threadIdx.x == 0) (void)xb_add(&bar[XB_XCNT(b.x)], 1u);
    return b;
}
__device__ __forceinline__ void xcd_barrier_complete(unsigned* bar, unsigned x, unsigned& nloc, unsigned& nx) {
    const unsigned G = gridDim.x * gridDim.y * gridDim.z;
    unsigned sum, cnt, mine, sp = 0u;
    for (;;) {
        sum = 0u; cnt = 0u; mine = 0u;
#pragma unroll
        for (unsigned j = 0; j < 16; ++j) { const unsigned c = xb_ld(&bar[XB_XCNT(j)]); sum += c; cnt += (c > 0u) ? 1u : 0u; mine = (j == x) ? c : mine; }
        if (sum == G) break;
        __builtin_amdgcn_s_sleep(1);
        if ((++sp & 255u) == 0u) { if (xb_ld(&bar[XB_TMO])) break; if (sp > XB_SPIN_CAP) { atomicAdd(&bar[XB_TMO], 1u); break; } }
    }
    nloc = mine > 0u ? mine : 1u; nx = cnt > 0u ? cnt : 1u;
}

__device__ __forceinline__ void xcd_barrier(const XcdBarrier& b) {
    asm volatile("s_waitcnt vmcnt(0)" ::: "memory");
    __syncthreads();
    if (threadIdx.x == 0) {
        unsigned* bar = b.bar;
        __builtin_amdgcn_s_waitcnt(0);
        unsigned nloc = b.st[0], nx = b.st[1];
        if (nloc == 0u) { xcd_barrier_complete(bar, b.x, nloc, nx); b.st[0] = nloc; b.st[1] = nx; }
        const unsigned old = xb_add(&bar[XB_XSUB(b.x)], 1u);
        const unsigned gen = old / nloc;
        if (old + 1u == (gen + 1u) * nloc) {
            __builtin_amdgcn_fence(__ATOMIC_RELEASE, "agent");
            asm volatile("s_waitcnt vmcnt(0)" ::: "memory");
            const unsigned og = xb_add(&bar[XB_TOP], 1u);
            const unsigned tg = og / nx;
            if (og + 1u == (tg + 1u) * nx) xb_add(&bar[XB_TOPGEN], 1u);
            else XB_SPIN(xb_ld(&bar[XB_TOPGEN]) == tg, bar);
            __builtin_amdgcn_fence(__ATOMIC_ACQUIRE, "agent");
            xb_add(&bar[XB_XGEN(b.x)], 1u);
            asm volatile("s_waitcnt vmcnt(0)" ::: "memory");
        } else {
            XB_SPIN(xb_ld(&bar[XB_XGEN(b.x)]) == gen, bar);
            __builtin_amdgcn_fence(__ATOMIC_ACQUIRE, "agent");
            asm volatile("s_waitcnt vmcnt(0)" ::: "memory");
        }
    }
    __syncthreads();
}

__device__ __forceinline__ float wave_sum(float v) {
#pragma unroll
    for (int o = 1; o < 64; o <<= 1) v += __shfl_xor(v, o);
    return v;
}
struct CvtDesc { const float* W; const float* gain; bf16* WT; int K, N, row_off, mode; };
__device__ __forceinline__ void cvt_item(const CvtDesc& d, LAS float* scr, int item, int lane) {
    const int nblk = d.N / 32, kb = item / nblk, nb = item % nblk, k0 = 64 * kb, n0 = 32 * nb;
    const int drow0 = d.mode == 0 ? d.row_off + n0 : ((n0 >> 7) * 256 + (n0 & 127) + (d.mode == 2 ? 128 : 0));
#pragma unroll 8
    for (int i = 0; i < 32; ++i) { const int kk = 2 * i + (lane >> 5); const float gn = d.gain ? d.gain[k0 + kk] : 1.0f; scr[kk * 33 + (lane & 31)] = d.W[(size_t)(k0 + kk) * d.N + n0 + (lane & 31)] * gn; }
    LDS_WAIT(); asm volatile("" ::: "memory");
    const int c = lane & 7;
#pragma unroll
    for (int j = 0; j < 4; ++j) { const int n = (lane >> 3) + 8 * j; const LAS float* s = scr + (8 * c) * 33 + n;
        v4u o; o.x = pk2(s[0 * 33], s[1 * 33]); o.y = pk2(s[2 * 33], s[3 * 33]); o.z = pk2(s[4 * 33], s[5 * 33]); o.w = pk2(s[6 * 33], s[7 * 33]);
        *(GAS v4u*)(d.WT + (size_t)(drow0 + n) * d.K + k0 + 8 * c) = o; }
    LDS_WAIT(); asm volatile("" ::: "memory");
}
template <int ND> __device__ __forceinline__ void cvt_run(const CvtDesc (&ds)[ND], LAS unsigned char* lds, int gw, int NGW, int wave, int lane) {
    LAS float* scr = (LAS float*)(lds + RING_OFF + wave * 16384);
    int total = 0;
#pragma unroll
    for (int i = 0; i < ND; ++i) total += (ds[i].K / 64) * (ds[i].N / 32);
    for (int it = gw; it < total; it += NGW) { int r = it;
#pragma unroll
        for (int i = 0; i < ND; ++i) { const int ni = (ds[i].K / 64) * (ds[i].N / 32); if (r >= 0 && r < ni) cvt_item(ds[i], scr, r, lane); r -= ni; } }
}
__device__ __forceinline__ void x_row_to_bf16(const float* xrow, bf16* orow, float* rstd_out, int lane) {
    const GAS f32x4* xr = (const GAS f32x4*)xrow + lane; f32x4 v[8]; float s = 0.f;
#pragma unroll
    for (int j = 0; j < 8; ++j) { v[j] = xr[64 * j]; s += (v[j][0] * v[j][0] + v[j][1] * v[j][1]) + (v[j][2] * v[j][2] + v[j][3] * v[j][3]); }
    s = wave_sum(s);
    GAS unsigned long long* o8 = (GAS unsigned long long*)orow + lane;
#pragma unroll
    for (int j = 0; j < 8; ++j) o8[64 * j] = (unsigned long long)pk2(v[j][0], v[j][1]) | ((unsigned long long)pk2(v[j][2], v[j][3]) << 32);
    if (lane == 0) *rstd_out = rsqrtf(s * (1.0f / D) + NORM_EPS);
}
__device__ __forceinline__ void sincos_d(double x, double& sn, double& cs) {
    const double n = __builtin_rint(x * 0.63661977236758134308);
    double r = __builtin_fma(-n, 1.57079632679489655800e+00, x); r = __builtin_fma(-n, 6.12323399573676603587e-17, r);
    const double z = r * r;
    const double s = r * (1.0 + z * (-1.0 / 6 + z * (1.0 / 120 + z * (-1.0 / 5040 + z * (1.0 / 362880 + z * (-1.0 / 39916800 + z * (1.0 / 6227020800.0)))))));
    const double c = 1.0 + z * (-0.5 + z * (1.0 / 24 + z * (-1.0 / 720 + z * (1.0 / 40320 + z * (-1.0 / 3628800 + z * (1.0 / 479001600 + z * (-1.0 / 87178291200.0)))))));
    const int q = (int)((long long)n & 3);
    sn = (q == 0) ? s : (q == 1) ? c : (q == 2) ? -s : -c;
    cs = (q == 0) ? c : (q == 1) ? -s : (q == 2) ? -c : s;
}
__device__ __forceinline__ void s5_pow(double lr, double li, double dt, double tau, double& pr, double& pi) {
    const double mag = exp(lr * dt * tau); double sn, cs; sincos_d(li * dt * tau, sn, cs); pr = mag * cs; pi = mag * sn;
}
struct S5In { const float *a_re, *a_im, *log_dt, *b_re, *b_im, *c_re, *c_im, *dsk; };
__device__ __forceinline__ void s5_tables_item(const S5In& in, LAS unsigned char* lds, unsigned char* ws, int g, int q, int tid) {
    LAS f32x2* pw = (LAS f32x2*)(lds + RING_OFF);
    LAS f32x2* bk = (LAS f32x2*)(lds + RING_OFF + 17408);
    LAS f32x2* cg = (LAS f32x2*)(lds + RING_OFF + 25600);
    LAS float* kt = (LAS float*)(lds + RING_OFF + 33792);
    const double dt = exp((double)in.log_dt[g]);
    for (int e = tid; e < 33 * 64; e += NWAVES * 64) { const int tau = e >> 6, p = e & 63; double pr, pi; s5_pow((double)in.a_re[g * 64 + p], (double)in.a_im[g * 64 + p], dt, (double)tau, pr, pi);
        pw[e] = (f32x2){(float)pr, (float)pi};
        if (tau == 32 && q == 0) ((f32x2*)(ws + WS_SMALL + SM_A32))[g * 64 + p] = (f32x2){(float)pr, (float)pi}; }
    if (q == 0 && tid < 64) { const int p = tid; double pr, pi; s5_pow((double)in.a_re[g * 64 + p], (double)in.a_im[g * 64 + p], dt, 1024.0, pr, pi); ((f32x2*)(ws + WS_SMALL + SM_A1024))[g * 64 + p] = (f32x2){(float)pr, (float)pi}; }
    for (int e = tid; e < 1024; e += NWAVES * 64) { const int p = e >> 4, c = e & 15; const double lr = (double)in.a_re[g * 64 + p], li = (double)in.a_im[g * 64 + p]; double ar, ai; s5_pow(lr, li, dt, 1.0, ar, ai);
        const double nr = ar - 1.0, ni = ai, den = lr * lr + li * li, kr = (nr * lr + ni * li) / den, ki = (ni * lr - nr * li) / den;
        const double br = (double)in.b_re[((size_t)g * 64 + p) * 16 + c], bi = (double)in.b_im[((size_t)g * 64 + p) * 16 + c];
        bk[e] = (f32x2){(float)(kr * br - ki * bi), (float)(kr * bi + ki * br)};
        const int c2 = e >> 6, p2 = e & 63; cg[e] = (f32x2){in.c_re[((size_t)g * 16 + c2) * 64 + p2], in.c_im[((size_t)g * 16 + c2) * 64 + p2]}; }
    LDS_WAIT(); __syncthreads();
    for (int e = tid; e < 32 * 256; e += NWAVES * 64) { const int tau = e >> 8, c2 = (e >> 4) & 15, c = e & 15; float s = 0.f;
        for (int p = 0; p < 64; ++p) { const f32x2 a = pw[tau * 64 + p], b = bk[p * 16 + c], cc = cg[c2 * 64 + p]; const float wr_ = a[0] * b[0] - a[1] * b[1], wi_ = a[0] * b[1] + a[1] * b[0]; s += cc[0] * wr_ - cc[1] * wi_; }
        if (tau == 0 && c2 == c) s += in.dsk[g * 16 + c];
        kt[e] = s; }
    LDS_WAIT(); __syncthreads();
    bf16* tm = (bf16*)(ws + WS_TM) + (size_t)g * 768 * 512;
    for (int e = tid; e < 192 * 64; e += NWAVES * 64) { const int rho = 192 * q + (e >> 6), kc = (e & 63) * 8, s = kc >> 4, c0 = kc & 15; float v[8];
#pragma unroll
        for (int j = 0; j < 8; ++j) { const int c = c0 + j; float x = 0.f;
            if (rho < 512) { const int t = rho >> 4, c2 = rho & 15; if (s <= t) x = kt[((t - s) * 16 + c2) * 16 + c]; }
            else if (rho < 640) { const int p = (rho - 512) & 63; const f32x2 a = pw[(31 - s) * 64 + p], b = bk[p * 16 + c]; x = rho < 576 ? (a[0] * b[0] - a[1] * b[1]) : (a[0] * b[1] + a[1] * b[0]); }
            v[j] = x; }
        v4u o; o.x = pk2(v[0], v[1]); o.y = pk2(v[2], v[3]); o.z = pk2(v[4], v[5]); o.w = pk2(v[6], v[7]);
        *(GAS v4u*)(tm + (size_t)rho * 512 + kc) = o; }
    bf16* gm = (bf16*)(ws + WS_GM) + (size_t)g * 512 * 256;
    for (int e = tid; e < 128 * 32; e += NWAVES * 64) { const int rho = 128 * q + (e >> 5), kc = (e & 31) * 8, t = rho >> 4, c2 = rho & 15; float v[8];
#pragma unroll
        for (int j = 0; j < 8; ++j) { const int k = kc + j; float x = 0.f;
            if (k < 128) { const int p = k & 63; const f32x2 a = pw[(t + 1) * 64 + p], cc = cg[c2 * 64 + p]; x = k < 64 ? (cc[0] * a[0] - cc[1] * a[1]) : -(cc[0] * a[1] + cc[1] * a[0]); }
            v[j] = x; }
        v4u o; o.x = pk2(v[0], v[1]); o.y = pk2(v[2], v[3]); o.z = pk2(v[4], v[5]); o.w = pk2(v[6], v[7]);
        *(GAS v4u*)(gm + (size_t)rho * 256 + kc) = o; }
    LDS_WAIT(); __syncthreads();
}
__device__ __forceinline__ void s5_scan(LAS unsigned char* lds, const unsigned char* ws, bf16* xin, int g, int wave, int lane) {
    const f32x2 a32 = ((const f32x2*)(ws + WS_SMALL + SM_A32))[g * 64 + lane], a1k = ((const f32x2*)(ws + WS_SMALL + SM_A1024))[g * 64 + lane];
    const float* eg = (const float*)(ws + WS_EST) + ((size_t)g * 256 + 32 * wave) * 128;
    float er[32], ei[32];
#pragma unroll
    for (int i = 0; i < 32; ++i) { er[i] = eg[i * 128 + lane]; ei[i] = eg[i * 128 + 64 + lane]; }
    float sr = 0.f, si = 0.f;
#pragma unroll
    for (int i = 0; i < 32; ++i) { const float nr = a32[0] * sr - a32[1] * si + er[i], ni = a32[0] * si + a32[1] * sr + ei[i]; sr = nr; si = ni; }
    LAS f32x2* seg = (LAS f32x2*)(lds + RING_OFF);
    seg[wave * 64 + lane] = (f32x2){sr, si};
    LDS_WAIT(); __syncthreads();
    sr = 0.f; si = 0.f;
    for (int w = 0; w < wave; ++w) { const f32x2 e = seg[w * 64 + lane]; const float nr = a1k[0] * sr - a1k[1] * si + e[0], ni = a1k[0] * si + a1k[1] * sr + e[1]; sr = nr; si = ni; }
    bf16* xo = xin + (size_t)(32 * wave) * 256;
#pragma unroll
    for (int i = 0; i < 32; ++i) { xo[i * 256 + lane] = (bf16)f2bf(sr); xo[i * 256 + 64 + lane] = (bf16)f2bf(si); xo[i * 256 + 128 + lane] = 0; xo[i * 256 + 192 + lane] = 0;
        const float nr = a32[0] * sr - a32[1] * si + er[i], ni = a32[0] * si + a32[1] * sr + ei[i]; sr = nr; si = ni; }
    VM_WAIT(); LDS_WAIT(); __syncthreads();
}
__device__ __forceinline__ void sgu_item(LAS unsigned char* lds, const unsigned char* ws, const float* ln_g, const float* ln_b, const float* b_s, int n, int h, int tid, int wave, int lane) {
    constexpr int RS = 136;
    LAS bf16* vT = (LAS bf16*)(lds + RING_OFF);
    LAS float* mu = (LAS float*)(lds + RING_OFF + 128 * RS * 2);
    LAS float* rsd = mu + 128;
    const int t0 = 128 * n, c0 = 128 * h;
    if (tid < 128) { const f32x4* p = (const f32x4*)((const float*)(ws + WS_LNST) + (size_t)(t0 + tid) * 32); float s1 = 0.f, s2 = 0.f;
#pragma unroll
        for (int i = 0; i < 8; ++i) { const f32x4 a = p[i]; s1 += a[0] + a[2]; s2 += a[1] + a[3]; }
        const float m_ = s1 * (1.0f / 1024.0f), var = s2 * (1.0f / 1024.0f) - m_ * m_; mu[tid] = m_; rsd[tid] = rsqrtf(fmaxf(var, 0.f) + NORM_EPS); }
    LDS_WAIT(); __syncthreads();
    { const int cgp = tid & 15; f32x4 g0 = *(const f32x4*)(ln_g + c0 + 8 * cgp), g1 = *(const f32x4*)(ln_g + c0 + 8 * cgp + 4), b0 = *(const f32x4*)(ln_b + c0 + 8 * cgp), b1 = *(const f32x4*)(ln_b + c0 + 8 * cgp + 4);
#pragma unroll
        for (int i = 0; i < 4; ++i) { const int s = (tid >> 4) + 32 * i; const v4u w = *(const GAS v4u*)((const bf16*)(ws + WS_VB) + (size_t)(t0 + s) * 1024 + c0 + 8 * cgp);
            const float m_ = mu[s], r_ = rsd[s]; float x[8] = {pg8::bf_lo(w.x), pg8::bf_hi(w.x), pg8::bf_lo(w.y), pg8::bf_hi(w.y), pg8::bf_lo(w.z), pg8::bf_hi(w.z), pg8::bf_lo(w.w), pg8::bf_hi(w.w)};
#pragma unroll
            for (int j = 0; j < 8; ++j) { const float gg = j < 4 ? g0[j & 3] : g1[j & 3], bb = j < 4 ? b0[j & 3] : b1[j & 3]; vT[(8 * cgp + j) * RS + s] = (bf16)f2bf((x[j] - m_) * r_ * gg + bb); } } }
    LDS_WAIT(); __syncthreads();
    const bf16* wsb = (const bf16*)(ws + WS_SMALL + SM_WSB) + (size_t)h * 128 * 128;
    const int fr = lane & 15, fq = lane >> 4, t = 16 * wave + fr;
    bf16x8 bfr[4];
#pragma unroll
    for (int kk = 0; kk < 4; ++kk) bfr[kk] = *(const GAS bf16x8*)(wsb + (size_t)t * 128 + kk * 32 + 8 * fq);
    f32x4 acc[8];
#pragma unroll
    for (int ct = 0; ct < 8; ++ct) { acc[ct] = (f32x4){0.f, 0.f, 0.f, 0.f};
#pragma unroll
        for (int kk = 0; kk < 4; ++kk) { const bf16x8 af = *(const LAS bf16x8*)(vT + (16 * ct + fr) * RS + kk * 32 + 8 * fq); acc[ct] = __builtin_amdgcn_mfma_f32_16x16x32_bf16(af, bfr[kk], acc[ct], 0, 0, 0); } }
    const float bias = b_s[h * 128 + t]; const size_t orow = (size_t)(t0 + t) * 1024 + c0;
#pragma unroll
    for (int ct = 0; ct < 8; ++ct) { const int c = 16 * ct + 4 * fq; const pg8::u32x2 uw = *(const GAS pg8::u32x2*)((const bf16*)(ws + WS_UB) + orow + c);
        pg8::u32x2 o; o.x = pg8::cvt_pk_bf16(pg8::bf_lo(uw.x) * (acc[ct][0] + bias), pg8::bf_hi(uw.x) * (acc[ct][1] + bias)); o.y = pg8::cvt_pk_bf16(pg8::bf_lo(uw.y) * (acc[ct][2] + bias), pg8::bf_hi(uw.y) * (acc[ct][3] + bias));
        *(GAS pg8::u32x2*)((bf16*)(ws + WS_YB) + orow + c) = o; }
    LDS_WAIT(); __syncthreads();
}
__device__ __forceinline__ void final_row(float* xrow, const float* ssrow, const float* fn, int lane) {
    float s = lane < 32 ? ssrow[lane] : 0.f; s = wave_sum(s); const float rstd = rsqrtf(s * (1.0f / D) + NORM_EPS);
    GAS f32x4* xr = (GAS f32x4*)xrow + lane; const GAS f32x4* gr = (const GAS f32x4*)fn + lane;
#pragma unroll
    for (int j = 0; j < 8; ++j) { const f32x4 v = xr[64 * j] * rstd * gr[64 * j]; xr[64 * j] = v; }
}

struct Args { const float* in[31]; float* out; unsigned char* ws; int ph_lo, ph_hi; };
enum { I_X = 0, I_F1N, I_F1G, I_F1U, I_F1D, I_MIXN, I_WIN, I_ARE, I_AIM, I_LDT, I_BRE, I_BIM, I_CRE, I_CIM, I_DSK, I_WGLU, I_BGLU, I_LNG, I_LNB, I_WS, I_BS, I_WBA, I_WBB, I_WG, I_BG, I_WOUT, I_F2N, I_F2G, I_F2U, I_F2D, I_FN };
typedef const __attribute__((address_space(4))) Args* KArgsP;
__device__ __forceinline__ KArgsP kargs() { KArgsP p = (KArgsP)__builtin_amdgcn_kernarg_segment_ptr(); asm volatile("" : "+s"(p)); return p; }
#define AIN(i) (kargs()->in[i])
__global__ void __launch_bounds__(NWAVES * 64, 2) mk_fwd(Args args_unused) {
    extern __shared__ __attribute__((aligned(16))) unsigned char lds_raw[];
    LAS unsigned char* lds = (LAS unsigned char*)lds_raw;
    const int tid = threadIdx.x, lane = tid & 63, wave = __builtin_amdgcn_readfirstlane(tid >> 6);
    const int G = gridDim.x, bx = blockIdx.x;
    const int vcu = (G % 8 == 0) ? (bx % 8) * (G / 8) + bx / 8 : bx;
    unsigned char* const ws = kargs()->ws;
    for (int u = tid; u < (LDS_BYTES - LDSCTL_OFF) / 4; u += NWAVES * 64) ((LAS unsigned*)(lds + LDSCTL_OFF))[u] = 0u;
    __syncthreads();
    XcdBarrier bar; bar.bar = (unsigned*)(ws + WS_CTL) + CW_BAR; bar.x = 0; bar.st = nullptr;
    if (N_LAUNCHES == 1) bar = xcd_barrier_post((unsigned*)(ws + WS_CTL) + CW_BAR, (volatile LAS unsigned*)(lds + MISC_OFF) + 8);
    const int lo = kargs()->ph_lo, hi = kargs()->ph_hi;
#ifndef PH_MASK
#define PH_MASK 0xfff
#endif
#define IN(k) (((PH_MASK >> (k)) & 1) && lo <= (k) && (k) < hi)
#define SEAM(k) do { if (IN(k) && IN((k) + 1)) xcd_barrier(bar); } while (0)
    const int gw = vcu * NWAVES + wave, NGW = G * NWAVES;
    bf16* const XB = (bf16*)(ws + WS_XB); bf16* const ACT = (bf16*)(ws + WS_ACT); float* const SS = (float*)(ws + WS_SS);
    LAS unsigned char* ring = lds + RING_OFF;

    if (IN(0)) {
        const CvtDesc ds[8] = {
            {AIN(I_F1G), AIN(I_F1N), (bf16*)(ws + WS_W1A), D, FF, 0, 1}, {AIN(I_F1U), AIN(I_F1N), (bf16*)(ws + WS_W1A), D, FF, 0, 2},
            {AIN(I_F1D), nullptr, (bf16*)(ws + WS_W2A), FF, D, 0, 0},
            {AIN(I_WIN), AIN(I_MIXN), (bf16*)(ws + WS_WMIX), D, 3072, 0, 0}, {AIN(I_WG), AIN(I_MIXN), (bf16*)(ws + WS_WMIX), D, 4096, 3072, 0},
            {AIN(I_WGLU), nullptr, (bf16*)(ws + WS_WGLU), SW, SW, 0, 0},
            {AIN(I_WBA), nullptr, (bf16*)(ws + WS_WA), SW, D, 0, 0}, {AIN(I_WBB), nullptr, (bf16*)(ws + WS_WB), SW, D, 0, 0} };
        cvt_run<8>(ds, lds, gw, NGW, wave, lane);
        const CvtDesc d2[1] = { {AIN(I_WOUT), nullptr, (bf16*)(ws + WS_WOUT), D, D, 0, 0} };
        cvt_run<1>(d2, lds, gw, NGW, wave, lane);
        for (int m = gw; m < M; m += NGW) x_row_to_bf16(AIN(I_X) + (size_t)m * D, XB + (size_t)m * D, (float*)(ws + WS_SMALL + SM_RSTD0) + m, lane);
        { const float* w_s = AIN(I_WS); bf16* wsb = (bf16*)(ws + WS_SMALL + SM_WSB);
          for (int e = bx * (NWAVES * 64) + tid; e < 8 * 128 * 128; e += G * NWAVES * 64) { const int t = (e >> 7) & 127, s = e & 127; wsb[e] = (bf16)f2bf(((t >> 6) >= (s >> 6)) ? w_s[e] : 0.f); } }
        __syncthreads();
        const S5In s5{AIN(I_ARE), AIN(I_AIM), AIN(I_LDT), AIN(I_BRE), AIN(I_BIM), AIN(I_CRE), AIN(I_CIM), AIN(I_DSK)};
        for (int it = bx; it < 256; it += G) s5_tables_item(s5, lds, ws, it & 63, it >> 6, tid);
    }
    SEAM(0);
    if (IN(1)) {
        pg8::Gemm g{XB, (const bf16*)(ws + WS_W1A), M, 2 * FF, D}; pg8::StaticOrder S; S.init(M, 2 * FF, G, bx);
        pg8::EpiFfnUp<0> E{ACT, FF, (const float*)(ws + WS_SMALL + SM_RSTD0)};
        pg8::gemm_phase<pg8::EpiFfnUp<0>, pg8::StaticOrder, true, true>(ring, g, S, E);
    }
    SEAM(1);
    if (IN(2)) {
        pg8::Gemm g{ACT, (const bf16*)(ws + WS_W2A), M, D, FF}; pg8::StaticOrder S; S.init(M, D, G, bx);
        pg8::EpiResid<true> E{AIN(I_X), kargs()->out, XB, SS, 0.5f};
        pg8::gemm_phase<pg8::EpiResid<true>, pg8::StaticOrder, true, true>(ring, g, S, E);
    }
    SEAM(2);
    if (IN(3)) {
        pg8::Gemm g{XB, (const bf16*)(ws + WS_WMIX), M, NMIX, D}; pg8::StaticOrder S; S.init(M, NMIX, G, bx);
        pg8::EpiMixIn E{(bf16*)(ws + WS_UA), (bf16*)(ws + WS_UB), (bf16*)(ws + WS_VB), (bf16*)(ws + WS_GT), (float*)(ws + WS_LNST), SS, AIN(I_BG)};
        pg8::gemm_phase<pg8::EpiMixIn, pg8::StaticOrder, true, true>(ring, g, S, E);
    }
    SEAM(3);
    if (IN(4)) {
        pg8::Gemm g{(const bf16*)(ws + WS_UA), (const bf16*)(ws + WS_TM), S5G * 256, 768 * S5G, 512}; pg8::BatchOrder S{192, 3, G, bx, false};
        pg8::EpiS5Loc E{(float*)(ws + WS_YLOC), (float*)(ws + WS_EST)};
        pg8::gemm_phase<pg8::EpiS5Loc, pg8::BatchOrder, true, true>(ring, g, S, E);
        __syncthreads();
        if (G == 256) {
            if (bx >= 192) for (int i = 0; i < 4; ++i) { const int it = (bx - 192) * 4 + i; sgu_item(lds, ws, AIN(I_LNG), AIN(I_LNB), AIN(I_BS), it >> 3, it & 7, tid, wave, lane); }
            { const int it = 256 + bx; sgu_item(lds, ws, AIN(I_LNG), AIN(I_LNB), AIN(I_BS), it >> 3, it & 7, tid, wave, lane); }
        } else { for (int it = bx; it < 512; it += G) sgu_item(lds, ws, AIN(I_LNG), AIN(I_LNB), AIN(I_BS), it >> 3, it & 7, tid, wave, lane); }
    }
    SEAM(4);
    if (IN(5)) {
        for (int L = bx; L < 128; L += G) s5_scan(lds, ws, (bf16*)(ws + WS_XIN) + (size_t)L * 256 * 256, L >> 1, wave, lane);
        pg8::Gemm g{(const bf16*)(ws + WS_XIN), (const bf16*)(ws + WS_GM), 128 * 256, 512 * S5G, 256}; pg8::BatchOrder S{128, 2, G, bx, true};
        pg8::EpiS5Out E{(const float*)(ws + WS_YLOC), (bf16*)(ws + WS_YG)};
        pg8::gemm_phase<pg8::EpiS5Out, pg8::BatchOrder, true, true>(ring, g, S, E);
    }
    SEAM(5);
    if (IN(6)) {
        pg8::Gemm g{(const bf16*)(ws + WS_YG), (const bf16*)(ws + WS_WGLU), M, SW, SW}; pg8::StaticOrder S; S.init(M, SW, G, bx);
        pg8::EpiGlu E{(const bf16*)(ws + WS_YG), (bf16*)(ws + WS_YA), AIN(I_BGLU)};
        pg8::gemm_phase<pg8::EpiGlu, pg8::StaticOrder, true, true>(ring, g, S, E);
    }
    SEAM(6);
    if (IN(7)) {
        { pg8::Gemm g{(const bf16*)(ws + WS_YA), (const bf16*)(ws + WS_WA), M, D, SW}; pg8::StaticOrder S; S.init(M, D, G, bx);
          pg8::EpiBranch<false> E{(const bf16*)(ws + WS_GT), (bf16*)(ws + WS_MG)};
          pg8::gemm_phase<pg8::EpiBranch<false>, pg8::StaticOrder, true, true>(ring, g, S, E); }
        __syncthreads();
        { pg8::Gemm g{(const bf16*)(ws + WS_YB), (const bf16*)(ws + WS_WB), M, D, SW}; pg8::StaticOrder S; S.init(M, D, G, bx);
          pg8::EpiBranch<true> E{(const bf16*)(ws + WS_GT) + 2048, (bf16*)(ws + WS_MG)};
          pg8::gemm_phase<pg8::EpiBranch<true>, pg8::StaticOrder, true, true>(ring, g, S, E); }
    }
    SEAM(7);
    if (IN(8)) {
        const CvtDesc ds[3] = { {AIN(I_F2G), AIN(I_F2N), (bf16*)(ws + WS_W1B), D, FF, 0, 1}, {AIN(I_F2U), AIN(I_F2N), (bf16*)(ws + WS_W1B), D, FF, 0, 2}, {AIN(I_F2D), nullptr, (bf16*)(ws + WS_W2B), FF, D, 0, 0} };
        cvt_run<3>(ds, lds, gw, NGW, wave, lane);
        __syncthreads();
        pg8::Gemm g{(const bf16*)(ws + WS_MG), (const bf16*)(ws + WS_WOUT), M, D, D}; pg8::StaticOrder S; S.init(M, D, G, bx);
        pg8::EpiResid<true> E{kargs()->out, kargs()->out, XB, SS, 1.0f};
        pg8::gemm_phase<pg8::EpiResid<true>, pg8::StaticOrder, true, true>(ring, g, S, E);
    }
    SEAM(8);
    if (IN(9)) {
        pg8::Gemm g{XB, (const bf16*)(ws + WS_W1B), M, 2 * FF, D}; pg8::StaticOrder S; S.init(M, 2 * FF, G, bx);
        pg8::EpiFfnUp<1> E{ACT, FF, SS};
        pg8::gemm_phase<pg8::EpiFfnUp<1>, pg8::StaticOrder, true, true>(ring, g, S, E);
    }
    SEAM(9);
    if (IN(10)) {
        pg8::Gemm g{ACT, (const bf16*)(ws + WS_W2B), M, D, FF}; pg8::StaticOrder S; S.init(M, D, G, bx);
        pg8::EpiResid<false> E{kargs()->out, kargs()->out, nullptr, SS, 0.5f};
        pg8::gemm_phase<pg8::EpiResid<false>, pg8::StaticOrder, true, true>(ring, g, S, E);
    }
    SEAM(10);
    if (IN(11)) { for (int m = gw; m < M; m += NGW) final_row(kargs()->out + (size_t)m * D, SS + (size_t)m * 32, AIN(I_FN), lane); }
#undef IN
#undef SEAM
}

extern "C" void kernel_launch(void* const* d_in, const int* in_sizes, int n_in, void* d_out, int out_size, void* d_ws, size_t ws_size, hipStream_t stream) {
    static int grid = 0;
    if (grid == 0) {
        if (n_in != 31 || in_sizes[0] != M * D || out_size != M * D || ws_size < WS_END) { fprintf(stderr, "kernel_launch: unexpected shapes: n_in %d in0 %d out %d ws %zu (need %zu)\n", n_in, n_in > 0 ? in_sizes[0] : -1, out_size, ws_size, (size_t)WS_END); grid = -1; return; }
        int dev = 0, cus = 0, per_cu = 0;
        if (hipGetDevice(&dev) != hipSuccess || hipDeviceGetAttribute(&cus, hipDeviceAttributeMultiprocessorCount, dev) != hipSuccess) { fprintf(stderr, "kernel_launch: device query failed\n"); grid = -1; return; }
        if (hipFuncSetAttribute((const void*)mk_fwd, hipFuncAttributeMaxDynamicSharedMemorySize, LDS_BYTES) != hipSuccess) { fprintf(stderr, "kernel_launch: hipFuncSetAttribute failed\n"); grid = -1; return; }
        if (hipOccupancyMaxActiveBlocksPerMultiprocessor(&per_cu, (const void*)mk_fwd, NWAVES * 64, LDS_BYTES) != hipSuccess || per_cu < 1) fprintf(stderr, "kernel_launch: occupancy query reports %d blocks per CU\n", per_cu);
        (void)hipGetLastError();
        grid = cus;
    }
    if (grid < 0) return;
    if (hipMemsetAsync((char*)d_ws + WS_CTL, 0, CTL_ZERO_BYTES, stream) != hipSuccess) { fprintf(stderr, "kernel_launch: memset failed\n"); return; }
    Args a{};
    for (int i = 0; i < 31; ++i) a.in[i] = (const float*)d_in[i];
    a.out = (float*)d_out; a.ws = (unsigned char*)d_ws;
    for (int li = 0; li < N_LAUNCHES; ++li) {
        a.ph_lo = (N_LAUNCHES == 1) ? 0 : li; a.ph_hi = (N_LAUNCHES == 1) ? PER_PHASE : li + 1;
        hipLaunchKernelGGL(mk_fwd, dim3(grid), dim3(NWAVES * 64), LDS_BYTES, stream, a);
        const hipError_t le = hipPeekAtLastError();
        if (le != hipSuccess) { fprintf(stderr, "kernel_launch: launch %d failed: %s\n", li, hipGetErrorName(le)); break; }
    }
}
```

```cpp
#include <hip/hip_runtime.h>
#include <cstdio>
#include <cstdint>
#ifndef MK_N_LAUNCHES
#define MK_N_LAUNCHES 1
#endif
namespace pg8 {
#define PG8_LAS __attribute__((address_space(3)))
typedef unsigned short bf16_t;
typedef short bf16x8 __attribute__((ext_vector_type(8)));
typedef float f32x4 __attribute__((ext_vector_type(4)));
typedef unsigned u32x4 __attribute__((ext_vector_type(4)));
constexpr int BM = 256, BK = 64, HALF = 128, HTB = HALF * BK * 2  , STAGE_BYTES = 8 * HTB, NXCD = 8, WGM = 8;

__host__ __device__ __forceinline__ int lds_byte(int r, int c) { const int st = (r >> 4) * 2 + (c >> 5), rr = r & 15, cc = c & 31, ob = rr * 64 + cc * 2; return st * 1024 + (ob ^ (((ob >> 9) & 1) << 5)); }
__host__ __device__ __forceinline__ void stage_rc(int b, int& R, int& C) { const int st = b / 1024, sb = b % 1024, swz = sb ^ (((sb >> 9) & 1) << 5); R = (st >> 1) * 16 + swz / 64; C = (st & 1) * 32 + (swz % 64) / 2; }
__host__ __device__ __forceinline__ int perm32(int rho) { const int n = rho >> 4, i = rho & 15; return 8 * (i >> 2) + 4 * n + (i & 3); }

struct Unit { int pm, pn; };
struct Gemm { const bf16_t* A; const bf16_t* Bt; int M, N, K; };

struct StaticOrder {
    int nM, nN, nwg, G, c;
    __host__ __device__ void init(int M, int N, int G_, int c_) { nM = M / BM; nN = N / BM; nwg = nM * nN; G = G_; c = c_; }
    __host__ __device__ bool next(int i, Unit& u) const {
        const long L = (long)i * G + c; if (L >= nwg) return false;
        int wgid = (int)L; { const int q = nwg / NXCD, r = nwg % NXCD, xcd = wgid % NXCD, off = wgid / NXCD; wgid = (xcd < r ? xcd * (q + 1) : r * (q + 1) + (xcd - r) * q) + off; }
        const int nig = WGM * nN, gid = wgid / nig, fm = gid * WGM, gsz = (nM - fm) < WGM ? (nM - fm) : WGM;
        u.pm = fm + ((wgid % nig) % gsz); u.pn = (wgid % nig) / gsz; return true;
    }
    __device__ __forceinline__ void a_ready(const Unit&) const {}
    __device__ __forceinline__ void done(const Unit&) const {}
};

__device__ __forceinline__ unsigned cvt_pk_bf16(float lo, float hi) { unsigned r; asm volatile("v_cvt_pk_bf16_f32 %0, %1, %2" : "=v"(r) : "v"(lo), "v"(hi)); return r; }

typedef float f32x2 __attribute__((ext_vector_type(2)));
typedef unsigned u32x2 __attribute__((ext_vector_type(2)));
__device__ __forceinline__ float sigm(float x) { return __builtin_amdgcn_rcpf(1.0f + __builtin_amdgcn_exp2f(-1.4426950408889634f * x)); }
__device__ __forceinline__ float silu_f(float x) { return x * sigm(x); }
__device__ __forceinline__ float gelu_f(float x) { return x * sigm(1.5957691216057308f * (x + 0.044715f * x * x * x)); }
__device__ __forceinline__ float bf_lo(unsigned w) { return __uint_as_float(w << 16); }
__device__ __forceinline__ float bf_hi(unsigned w) { return __uint_as_float(w & 0xffff0000u); }
__device__ __forceinline__ u32x4 pack8(const f32x4 a, const f32x4 b) { u32x4 w; w.x = cvt_pk_bf16(a[0], a[1]); w.y = cvt_pk_bf16(a[2], a[3]); w.z = cvt_pk_bf16(b[0], b[1]); w.w = cvt_pk_bf16(b[2], b[3]); return w; }
__device__ __forceinline__ void unpack8(const u32x4 w, f32x4& a, f32x4& b) { a = (f32x4){bf_lo(w.x), bf_hi(w.x), bf_lo(w.y), bf_hi(w.y)}; b = (f32x4){bf_lo(w.z), bf_hi(w.z), bf_lo(w.w), bf_hi(w.w)}; }
constexpr float NORM_EPS = 1e-6f;
constexpr int DM = 2048;
template <int RMODE> __device__ __forceinline__ float row_rstd(const float* rs, int r, int fq) {
    if (RMODE == 0) return rs[r];
    const f32x4* p = (const f32x4*)(rs + (size_t)r * 32 + 8 * fq); const f32x4 a = p[0], b = p[1];
    float s = ((a[0] + a[1]) + (a[2] + a[3])) + ((b[0] + b[1]) + (b[2] + b[3]));
    s += __shfl_xor(s, 16); s += __shfl_xor(s, 32);
    return rsqrtf(s * (1.0f / DM) + NORM_EPS);
}
template <int RMODE> struct EpiFfnUp {
    static constexpr bool PERM = true, AFTER_DRAIN = false;
    bf16_t* act; int ldc; const float* rs;
    __device__ __forceinline__ void operator()(const f32x4 (&acc)[2][2][4][2], const Unit& u, int wr, int wc, int fr, int fq) const {
        asm volatile("" : "+v"(fr), "+v"(fq));
        const int row0 = u.pm * BM + wr * 64 + fr, col0 = u.pn * HALF + wc * 32 + 8 * fq;
#pragma unroll
        for (int ai = 0; ai < 2; ++ai)
#pragma unroll
            for (int m = 0; m < 4; ++m) { const int r = row0 + ai * HALF + m * 16; const float rstd = row_rstd<RMODE>(rs, r, fq);
                f32x4 o0, o1;
#pragma unroll
                for (int j = 0; j < 4; ++j) { o0[j] = silu_f(acc[ai][0][m][0][j] * rstd) * (acc[ai][1][m][0][j] * rstd); o1[j] = silu_f(acc[ai][0][m][1][j] * rstd) * (acc[ai][1][m][1][j] * rstd); }
                *(u32x4*)(act + (size_t)r * ldc + col0) = pack8(o0, o1); }
    }
};
template <bool WB16> struct EpiResid {
    static constexpr bool PERM = true, AFTER_DRAIN = false;
    const float* xold; float* xnew; bf16_t* xb; float* ss; float scale;
    __device__ __forceinline__ void operator()(const f32x4 (&acc)[2][2][4][2], const Unit& u, int wr, int wc, int fr, int fq) const {
        asm volatile("" : "+v"(fr), "+v"(fq));
        const int row0 = u.pm * BM + wr * 64 + fr, col0 = u.pn * BM + wc * 32 + 8 * fq;
#pragma unroll
        for (int ai = 0; ai < 2; ++ai)
#pragma unroll
            for (int m = 0; m < 4; ++m) { const int r = row0 + ai * HALF + m * 16; float q = 0.f;
#pragma unroll
                for (int bj = 0; bj < 2; ++bj) { const size_t off = (size_t)r * DM + col0 + bj * HALF;
                    const f32x4 v0 = *(const f32x4*)(xold + off) + acc[ai][bj][m][0] * scale, v1 = *(const f32x4*)(xold + off + 4) + acc[ai][bj][m][1] * scale;
                    *(f32x4*)(xnew + off) = v0; *(f32x4*)(xnew + off + 4) = v1;
                    q += ((v0[0] * v0[0] + v0[1] * v0[1]) + (v0[2] * v0[2] + v0[3] * v0[3])) + ((v1[0] * v1[0] + v1[1] * v1[1]) + (v1[2] * v1[2] + v1[3] * v1[3]));
                    if (WB16) *(u32x4*)(xb + off) = pack8(v0, v1); }
                q += __shfl_xor(q, 16); q += __shfl_xor(q, 32);
                if (fq == 0) ss[(size_t)r * 32 + u.pn * 4 + wc] = q; }
    }
};
struct EpiMixIn {
    static constexpr bool PERM = true, AFTER_DRAIN = false;
    bf16_t *ua, *ub, *vb, *gt; float* lnst; const float* rs; const float* bgate;
    __device__ __forceinline__ void operator()(const f32x4 (&acc)[2][2][4][2], const Unit& u, int wr, int wc, int fr, int fq) const {
        asm volatile("" : "+v"(fr), "+v"(fq));
        const int row0 = u.pm * BM + wr * 64 + fr, colw = wc * 32 + 8 * fq;
        const int kind = u.pn < 4 ? 0 : (u.pn < 8 ? 1 : (u.pn < 12 ? 2 : 3));
#pragma unroll
        for (int ai = 0; ai < 2; ++ai)
#pragma unroll
            for (int m = 0; m < 4; ++m) { const int r = row0 + ai * HALF + m * 16; const float rstd = row_rstd<1>(rs, r, fq);
                if (kind == 0) {
#pragma unroll
                    for (int bj = 0; bj < 2; ++bj) { const int c = u.pn * BM + bj * HALF + colw;
                        *(u32x4*)(ua + ((size_t)(c >> 4) * 8192 + r) * 16 + (c & 15)) = pack8(acc[ai][bj][m][0] * rstd, acc[ai][bj][m][1] * rstd); }
                } else if (kind == 1) {
#pragma unroll
                    for (int bj = 0; bj < 2; ++bj) { const int c = (u.pn - 4) * BM + bj * HALF + colw; f32x4 o0, o1;
#pragma unroll
                        for (int j = 0; j < 4; ++j) { o0[j] = gelu_f(acc[ai][bj][m][0][j] * rstd); o1[j] = gelu_f(acc[ai][bj][m][1][j] * rstd); }
                        *(u32x4*)(ub + (size_t)r * 1024 + c) = pack8(o0, o1); }
                } else if (kind == 2) { float s1 = 0.f, s2 = 0.f;
#pragma unroll
                    for (int bj = 0; bj < 2; ++bj) { const int c = (u.pn - 8) * BM + bj * HALF + colw; f32x4 o0, o1;
#pragma unroll
                        for (int j = 0; j < 4; ++j) { o0[j] = gelu_f(acc[ai][bj][m][0][j] * rstd); o1[j] = gelu_f(acc[ai][bj][m][1][j] * rstd); s1 += o0[j] + o1[j]; s2 += o0[j] * o0[j] + o1[j] * o1[j]; }
                        *(u32x4*)(vb + (size_t)r * 1024 + c) = pack8(o0, o1); }
                    s1 += __shfl_xor(s1, 16); s1 += __shfl_xor(s1, 32); s2 += __shfl_xor(s2, 16); s2 += __shfl_xor(s2, 32);
                    if (fq == 0) *(f32x2*)(lnst + ((size_t)r * 16 + (u.pn - 8) * 4 + wc) * 2) = (f32x2){s1, s2};
                } else {
#pragma unroll
                    for (int bj = 0; bj < 2; ++bj) { const int c = (u.pn - 12) * BM + bj * HALF + colw; const f32x4 b0 = *(const f32x4*)(bgate + c), b1 = *(const f32x4*)(bgate + c + 4); f32x4 o0, o1;
#pragma unroll
                        for (int j = 0; j < 4; ++j) { o0[j] = sigm(acc[ai][bj][m][0][j] * rstd + b0[j]); o1[j] = sigm(acc[ai][bj][m][1][j] * rstd + b1[j]); }
                        *(u32x4*)(gt + (size_t)r * 4096 + c) = pack8(o0, o1); }
                } }
    }
};
struct EpiS5Loc {
    static constexpr bool PERM = true, AFTER_DRAIN = false;
    float* yloc; float* est;
    __device__ __forceinline__ void operator()(const f32x4 (&acc)[2][2][4][2], const Unit& u, int wr, int wc, int fr, int fq) const {
        asm volatile("" : "+v"(fr), "+v"(fq));
        const int g = u.pn / 3, j3 = u.pn - 3 * g, row0 = wr * 64 + fr, colw = wc * 32 + 8 * fq;
#pragma unroll
        for (int ai = 0; ai < 2; ++ai)
#pragma unroll
            for (int m = 0; m < 4; ++m) { const int n = row0 + ai * HALF + m * 16;
                if (j3 < 2) {
#pragma unroll
                    for (int bj = 0; bj < 2; ++bj) { float* p = yloc + ((size_t)g * 256 + n) * 512 + j3 * BM + bj * HALF + colw; *(f32x4*)p = acc[ai][bj][m][0]; *(f32x4*)(p + 4) = acc[ai][bj][m][1]; }
                } else { float* p = est + ((size_t)g * 256 + n) * 128 + colw; *(f32x4*)p = acc[ai][0][m][0]; *(f32x4*)(p + 4) = acc[ai][0][m][1]; } }
    }
};
struct EpiS5Out {
    static constexpr bool PERM = true, AFTER_DRAIN = false;
    const float* yloc; bf16_t* yg;
    __device__ __forceinline__ void operator()(const f32x4 (&acc)[2][2][4][2], const Unit& u, int wr, int wc, int fr, int fq) const {
        asm volatile("" : "+v"(fr), "+v"(fq));
        const int g = u.pn >> 1, j2 = u.pn & 1, row0 = wr * 64 + fr, colw = wc * 32 + 8 * fq;
#pragma unroll
        for (int ai = 0; ai < 2; ++ai)
#pragma unroll
            for (int m = 0; m < 4; ++m) { const int n = row0 + ai * HALF + m * 16;
#pragma unroll
                for (int bj = 0; bj < 2; ++bj) { const int col = j2 * BM + bj * HALF + colw; const float* p = yloc + ((size_t)g * 256 + n) * 512 + col;
                    const f32x4 y0 = *(const f32x4*)p + acc[ai][bj][m][0], y1 = *(const f32x4*)(p + 4) + acc[ai][bj][m][1]; f32x4 o0, o1;
#pragma unroll
                    for (int j = 0; j < 4; ++j) { o0[j] = gelu_f(y0[j]); o1[j] = gelu_f(y1[j]); }
                    *(u32x4*)(yg + ((size_t)(32 * n + (col >> 4))) * 1024 + 16 * g + (col & 15)) = pack8(o0, o1); } }
    }
};
struct EpiGlu {
    static constexpr bool PERM = true, AFTER_DRAIN = false;
    const bf16_t* yg; bf16_t* ya; const float* bglu;
    __device__ __forceinline__ void operator()(const f32x4 (&acc)[2][2][4][2], const Unit& u, int wr, int wc, int fr, int fq) const {
        asm volatile("" : "+v"(fr), "+v"(fq));
        const int row0 = u.pm * BM + wr * 64 + fr, col0 = u.pn * BM + wc * 32 + 8 * fq;
#pragma unroll
        for (int ai = 0; ai < 2; ++ai)
#pragma unroll
            for (int m = 0; m < 4; ++m) { const int r = row0 + ai * HALF + m * 16;
#pragma unroll
                for (int bj = 0; bj < 2; ++bj) { const int c = col0 + bj * HALF; const f32x4 b0 = *(const f32x4*)(bglu + c), b1 = *(const f32x4*)(bglu + c + 4);
                    f32x4 y0, y1; unpack8(*(const u32x4*)(yg + (size_t)r * 1024 + c), y0, y1); f32x4 o0, o1;
#pragma unroll
                    for (int j = 0; j < 4; ++j) { o0[j] = y0[j] * sigm(acc[ai][bj][m][0][j] + b0[j]); o1[j] = y1[j] * sigm(acc[ai][bj][m][1][j] + b1[j]); }
                    *(u32x4*)(ya + (size_t)r * 1024 + c) = pack8(o0, o1); } }
    }
};
template <bool SECOND> struct EpiBranch {
    static constexpr bool PERM = true, AFTER_DRAIN = false;
    const bf16_t* gt; bf16_t* mg;
    __device__ __forceinline__ void operator()(const f32x4 (&acc)[2][2][4][2], const Unit& u, int wr, int wc, int fr, int fq) const {
        asm volatile("" : "+v"(fr), "+v"(fq));
        const int row0 = u.pm * BM + wr * 64 + fr, col0 = u.pn * BM + wc * 32 + 8 * fq;
#pragma unroll
        for (int ai = 0; ai < 2; ++ai)
#pragma unroll
            for (int m = 0; m < 4; ++m) { const int r = row0 + ai * HALF + m * 16;
#pragma unroll
                for (int bj = 0; bj < 2; ++bj) { const int c = col0 + bj * HALF; f32x4 g0, g1; unpack8(*(const u32x4*)(gt + (size_t)r * 4096 + c), g0, g1);
                    f32x4 o0 = g0 * acc[ai][bj][m][0], o1 = g1 * acc[ai][bj][m][1];
                    if (SECOND) { f32x4 p0, p1; unpack8(*(const u32x4*)(mg + (size_t)r * DM + c), p0, p1); o0 += p0; o1 += p1; }
                    *(u32x4*)(mg + (size_t)r * DM + c) = pack8(o0, o1); } }
    }
};
struct BatchOrder {
    int nunits, NJ, G, c; bool AL;
    __device__ __forceinline__ bool next(int i, Unit& u) const { const int L = i * G + c; if (L >= nunits) return false; u.pm = AL ? L : L / NJ; u.pn = L; return true; }
    __device__ __forceinline__ void a_ready(const Unit&) const {}
    __device__ __forceinline__ void done(const Unit&) const {}
};

template <class Epi, class Sched, bool ALIGN_EPI = false, bool SP2 = false>
__device__ __forceinline__ void gemm_phase(PG8_LAS unsigned char* lds, const Gemm g, const Sched& S, const Epi& E) {
    const int tid = threadIdx.x, wid = __builtin_amdgcn_readfirstlane(tid >> 6), lane = tid & 63, wr = wid >> 2, wc = wid & 3, fr = lane & 15, fq = lane >> 4;
    const int K = g.K, nt = K / BK;
    unsigned voffA[2], voffB[2];
#pragma unroll
    for (int i = 0; i < 2; ++i) { int R, C; stage_rc(tid * 16 + i * 8192, R, C); const int Rb = Epi::PERM ? ((R & ~31) + perm32(R & 31)) : R;
        voffA[i] = (unsigned)(R * K + C) * 2u; voffB[i] = (unsigned)(Rb * K + C) * 2u; }
    const size_t kstep = (size_t)(BK * 2);
    const size_t hstep = (size_t)HALF * K * 2;
    const size_t tstep = 2 * hstep;
    const unsigned ldsw = (unsigned)wid * 1024u;
    const int aoff = lds_byte(wr * 64 + fr, fq * 8), boff = lds_byte(wc * 32 + fr, fq * 8);
#define PG8_SA(b, h) (((b) * 2 + (h)) * HTB)
#define PG8_SB(b, h) ((4 + (b) * 2 + (h)) * HTB)
#define PG8_STAGE(bufoff, gbase, voff) do { _Pragma("unroll") for (int _i = 0; _i < 2; ++_i) \
        __builtin_amdgcn_global_load_lds((const unsigned*)((const char*)(gbase) + (voff)[_i]), (PG8_LAS unsigned*)(lds + (bufoff) + ldsw + _i * 8192), 16, 0, 0); } while (0)
#define PG8_LDA(dst, b, h) do { _Pragma("unroll") for (int m = 0; m < 4; ++m) _Pragma("unroll") for (int k = 0; k < 2; ++k) dst[m][k] = *(const PG8_LAS bf16x8*)(lds + PG8_SA(b, h) + aoff + m * 2048 + k * 1024); } while (0)
#define PG8_LDB(dst, b, h) do { _Pragma("unroll") for (int n = 0; n < 2; ++n) _Pragma("unroll") for (int k = 0; k < 2; ++k) dst[n][k] = *(const PG8_LAS bf16x8*)(lds + PG8_SB(b, h) + boff + n * 2048 + k * 1024); } while (0)
#define PG8_MMA(ai, bj, At, Bt) do { __builtin_amdgcn_s_setprio(1); _Pragma("unroll") for (int m = 0; m < 4; ++m) _Pragma("unroll") for (int n = 0; n < 2; ++n) _Pragma("unroll") for (int k = 0; k < 2; ++k) \
        acc[ai][bj][m][n] = __builtin_amdgcn_mfma_f32_16x16x32_bf16(Bt[n][k], At[m][k], acc[ai][bj][m][n], 0, 0, 0); __builtin_amdgcn_s_setprio(0); } while (0)
#define PG8_WAIT_V(n) asm volatile("s_waitcnt vmcnt(" #n ")" ::: "memory")
#define PG8_WAIT_L(n) asm volatile("s_waitcnt lgkmcnt(" #n ")" ::: "memory")
#define PG8_BAR __builtin_amdgcn_s_barrier()
#define PG8_SCHED __builtin_amdgcn_sched_barrier(0)
    Unit cur, nxt; int ui = 0;
    if (!S.next(0, cur)) return;
    f32x4 acc[2][2][4][2];
#pragma unroll
    for (int a = 0; a < 2; ++a)
#pragma unroll
        for (int b = 0; b < 2; ++b)
#pragma unroll
            for (int m = 0; m < 4; ++m)
#pragma unroll
                for (int n = 0; n < 2; ++n) acc[a][b][m][n] = (f32x4){0.f, 0.f, 0.f, 0.f};
    bf16x8 At[4][2], B0[2][2], B1[2][2];
    const char* cA = (const char*)g.A + (size_t)cur.pm * tstep; const char* cB = (const char*)g.Bt + (size_t)cur.pn * tstep;
    S.a_ready(cur);
    if constexpr (SP2) {
        PG8_STAGE(PG8_SB(0, 0), cB, voffB); PG8_STAGE(PG8_SB(0, 1), cB + hstep, voffB); PG8_STAGE(PG8_SA(0, 0), cA, voffA); PG8_STAGE(PG8_SA(0, 1), cA + hstep, voffA);
        if (wr == 1) PG8_BAR;
        PG8_WAIT_V(2); PG8_BAR;
        PG8_STAGE(PG8_SB(1, 0), cB + kstep, voffB); PG8_STAGE(PG8_SA(1, 0), cA + kstep, voffA); PG8_STAGE(PG8_SB(1, 1), cB + hstep + kstep, voffB);
        PG8_WAIT_V(6); PG8_BAR;
    } else {
        PG8_STAGE(PG8_SB(0, 0), cB, voffB); PG8_STAGE(PG8_SA(0, 0), cA, voffA); PG8_STAGE(PG8_SB(0, 1), cB + hstep, voffB); PG8_STAGE(PG8_SA(0, 1), cA + hstep, voffA);
        if (wr == 1) PG8_BAR;
        PG8_WAIT_V(4); PG8_BAR;
        PG8_STAGE(PG8_SB(1, 0), cB + kstep, voffB); PG8_STAGE(PG8_SA(1, 0), cA + kstep, voffA); PG8_STAGE(PG8_SB(1, 1), cB + hstep + kstep, voffB);
        PG8_WAIT_V(6); PG8_BAR;
    }
    for (;;) {
        const bool has_next = S.next(ui + 1, nxt);
        const char* nA = has_next ? (const char*)g.A + (size_t)nxt.pm * tstep : cA; const char* nB = has_next ? (const char*)g.Bt + (size_t)nxt.pn * tstep : cB;
#pragma nounroll
        for (int t = 0; t < nt; t += 2) {
            const bool last = (t == nt - 2);
            const char* a1 = cA + (size_t)(t + 1) * kstep;
            const char* a2 = last ? nA : cA + (size_t)(t + 2) * kstep; const char* b2 = last ? nB : cB + (size_t)(t + 2) * kstep;
            const char* a3 = a2 + kstep; const char* b3 = b2 + kstep;
            if (last && has_next) S.a_ready(nxt);
            if constexpr (SP2) {
            PG8_LDB(B0, 0, 0); PG8_LDB(B1, 0, 1); PG8_SCHED; PG8_LDA(At, 0, 0); PG8_STAGE(PG8_SA(1, 1), a1 + hstep, voffA);
            PG8_WAIT_V(8); PG8_WAIT_L(0); PG8_BAR; PG8_MMA(0, 0, At, B0); PG8_MMA(0, 1, At, B1); PG8_BAR; PG8_SCHED;
            PG8_LDA(At, 0, 1); PG8_STAGE(PG8_SB(0, 0), b2, voffB); PG8_STAGE(PG8_SB(0, 1), b2 + hstep, voffB); PG8_STAGE(PG8_SA(0, 0), a2, voffA);
            PG8_WAIT_V(8); PG8_WAIT_L(0); PG8_BAR; PG8_MMA(1, 0, At, B0); PG8_MMA(1, 1, At, B1); PG8_BAR; PG8_SCHED;
            PG8_LDB(B0, 1, 0); PG8_LDB(B1, 1, 1); PG8_SCHED; PG8_LDA(At, 1, 0); PG8_STAGE(PG8_SA(0, 1), a2 + hstep, voffA);
            PG8_WAIT_V(8); PG8_WAIT_L(0); PG8_BAR; PG8_MMA(0, 0, At, B0); PG8_MMA(0, 1, At, B1); PG8_BAR; PG8_SCHED;
            PG8_LDA(At, 1, 1); PG8_STAGE(PG8_SB(1, 0), b3, voffB); PG8_STAGE(PG8_SB(1, 1), b3 + hstep, voffB); PG8_STAGE(PG8_SA(1, 0), a3, voffA);
            PG8_WAIT_V(8); PG8_WAIT_L(0); PG8_BAR; PG8_MMA(1, 0, At, B0); PG8_MMA(1, 1, At, B1); PG8_BAR; PG8_SCHED;
            } else {
            PG8_LDB(B0, 0, 0); PG8_SCHED; PG8_LDA(At, 0, 0); PG8_STAGE(PG8_SA(1, 1), a1 + hstep, voffA);
            PG8_WAIT_L(8); PG8_BAR; PG8_WAIT_L(0); PG8_MMA(0, 0, At, B0); PG8_BAR; PG8_SCHED;
            PG8_LDB(B1, 0, 1); PG8_STAGE(PG8_SB(0, 0), b2, voffB);
            PG8_BAR; PG8_WAIT_L(0); PG8_MMA(0, 1, At, B1); PG8_BAR;
            PG8_LDA(At, 0, 1); PG8_STAGE(PG8_SA(0, 0), a2, voffA);
            PG8_BAR; PG8_WAIT_L(0); PG8_MMA(1, 0, At, B0); PG8_BAR; PG8_SCHED;
            PG8_STAGE(PG8_SB(0, 1), b2 + hstep, voffB);
            PG8_WAIT_V(6); PG8_BAR; PG8_MMA(1, 1, At, B1); PG8_BAR;
            PG8_LDB(B0, 1, 0); PG8_SCHED; PG8_LDA(At, 1, 0); PG8_STAGE(PG8_SA(0, 1), a2 + hstep, voffA);
            PG8_WAIT_L(8); PG8_BAR; PG8_WAIT_L(0); PG8_MMA(0, 0, At, B0); PG8_BAR; PG8_SCHED;
            PG8_LDB(B1, 1, 1); PG8_STAGE(PG8_SB(1, 0), b3, voffB);
            PG8_BAR; PG8_WAIT_L(0); PG8_MMA(0, 1, At, B1); PG8_BAR;
            PG8_LDA(At, 1, 1); PG8_STAGE(PG8_SA(1, 0), a3, voffA);
            PG8_BAR; PG8_WAIT_L(0); PG8_MMA(1, 0, At, B0); PG8_BAR; PG8_SCHED;
            PG8_STAGE(PG8_SB(1, 1), b3 + hstep, voffB);
            PG8_WAIT_V(6); PG8_BAR; PG8_MMA(1, 1, At, B1); PG8_BAR;
            }
        }
        if constexpr (ALIGN_EPI) { if (wr == 0) PG8_BAR; }
        if constexpr (!Epi::AFTER_DRAIN) { E(acc, cur, wr, wc, fr, fq); S.done(cur); }
        if (!has_next) break;
#pragma unroll
        for (int a = 0; a < 2; ++a)
#pragma unroll
            for (int b = 0; b < 2; ++b)
#pragma unroll
                for (int m = 0; m < 4; ++m)
#pragma unroll
                    for (int n = 0; n < 2; ++n) acc[a][b][m][n] = (f32x4){0.f, 0.f, 0.f, 0.f};
        cur = nxt; cA = nA; cB = nB; ++ui;
        if constexpr (ALIGN_EPI) { if (wr == 1) PG8_BAR; }
    }
    PG8_WAIT_V(0);
    if constexpr (!ALIGN_EPI) { if (wr == 0) PG8_BAR; }
    PG8_BAR;
    if constexpr (Epi::AFTER_DRAIN) { E.fused(acc, cur, wr, wc, fr, fq, lds, wid, lane); S.done(cur); }
#undef PG8_SA
#undef PG8_SB
#undef PG8_STAGE
#undef PG8_LDA
#undef PG8_LDB
#undef PG8_MMA
#undef PG8_WAIT_V
#undef PG8_WAIT_L
#undef PG8_BAR
#undef PG8_SCHED
}
}

constexpr int NWAVES = 8;
constexpr int N_LAUNCHES = MK_N_LAUNCHES;
constexpr int PER_PHASE = 12;
constexpr int M = 8192, D = 2048, FF = 5632, NMIX = 7168, SW = 1024;
constexpr int S5G = 64, S5P = 64, S5C = 16, LC = 32, NCH = M / LC;
constexpr size_t MiB = 1u << 20;
constexpr size_t WS_CTL = 0, CTL_ZERO_BYTES = 65536;
constexpr size_t WS_SMALL = 1 * MiB;
constexpr size_t SM_RSTD0 = 0, SM_A32 = 65536, SM_A1024 = 131072, SM_WSB = 262144;
constexpr size_t WS_SS = 2 * MiB, WS_LNST = 3 * MiB;
constexpr size_t WS_W1A = 4 * MiB, WS_W2A = 48 * MiB, WS_WMIX = 70 * MiB, WS_WGLU = 98 * MiB, WS_WA = 100 * MiB, WS_WB = 104 * MiB, WS_WOUT = 108 * MiB;
constexpr size_t WS_XB = 116 * MiB, WS_YLOC = WS_XB;
constexpr size_t WS_ACT = 148 * MiB;
constexpr size_t WS_GT = WS_ACT, WS_UB = 212 * MiB, WS_EST = 228 * MiB;
constexpr size_t WS_UA = 236 * MiB, WS_YA = WS_UA, WS_VB = 252 * MiB, WS_YB = 268 * MiB, WS_YG = 284 * MiB, WS_XIN = 300 * MiB, WS_GM = 316 * MiB;
constexpr size_t WS_W1B = 236 * MiB, WS_W2B = 280 * MiB;
constexpr size_t WS_TM = 332 * MiB, WS_MG = WS_TM, WS_END = 380 * MiB;
static_assert(WS_W1A + (size_t)2 * FF * D * 2 <= WS_W2A && WS_W2A + (size_t)D * FF * 2 <= WS_WMIX && WS_WMIX + (size_t)NMIX * D * 2 <= WS_WGLU, "ws map 1");
static_assert(WS_XB + (size_t)M * D * 2 <= WS_ACT && WS_YLOC + (size_t)S5G * NCH * 512 * 4 <= WS_ACT && WS_ACT + (size_t)M * FF * 2 <= WS_UA, "ws map 2");
static_assert(WS_GT + (size_t)M * 4096 * 2 <= WS_UB && WS_EST + (size_t)S5G * NCH * 128 * 4 <= WS_UA && WS_XIN + (size_t)128 * 256 * 256 * 2 <= WS_GM && WS_GM + (size_t)S5G * 512 * 256 * 2 <= WS_TM, "ws map 3");
static_assert(WS_W1B + (size_t)2 * FF * D * 2 <= WS_W2B && WS_W2B + (size_t)D * FF * 2 <= WS_GM && WS_TM + (size_t)S5G * 768 * 512 * 2 <= WS_END && WS_MG + (size_t)M * D * 2 <= WS_END, "ws map 4");
constexpr int CW_BAR = 4096;
constexpr int RING_OFF = 0, RING_BYTES = 131072, LDSCTL_OFF = RING_BYTES, MISC_OFF = LDSCTL_OFF + 320, LDS_BYTES = 147456;

#define GAS __attribute__((address_space(1)))
#define LAS __attribute__((address_space(3)))
typedef unsigned short bf16;
typedef unsigned v4u __attribute__((ext_vector_type(4)));
typedef float f32x4 __attribute__((ext_vector_type(4)));
typedef float f32x2 __attribute__((ext_vector_type(2)));
typedef short bf16x8 __attribute__((ext_vector_type(8)));
typedef GAS unsigned gu32;
#define RLX_AGENT __ATOMIC_RELAXED, __HIP_MEMORY_SCOPE_AGENT
using pg8::NORM_EPS;
#define LDS_WAIT() asm volatile("s_waitcnt lgkmcnt(0)" ::: "memory")
#define VM_WAIT() asm volatile("s_waitcnt vmcnt(0)" ::: "memory")
__device__ __forceinline__ unsigned f2bf(float f) { unsigned u = __builtin_bit_cast(unsigned, f); return (u + 0x7fffu + ((u >> 16) & 1u)) >> 16; }
__device__ __forceinline__ unsigned pk2(float lo, float hi) { return f2bf(lo) | (f2bf(hi) << 16); }

#define XB_TMO      128
#define XB_XCNT(j)  (256  + 64 * (j))
#define XB_XSUB(j)  (1280 + 64 * (j))
#define XB_XGEN(j)  (2304 + 64 * (j))
#define XB_TOP      3328
#define XB_TOPGEN   3392
#define XCD_BAR_WORDS 3456
#define XB_SPIN_CAP (1u << 18)

__device__ __forceinline__ unsigned xb_ld(unsigned* p)              { return __hip_atomic_load(p, __ATOMIC_RELAXED, __HIP_MEMORY_SCOPE_AGENT); }
__device__ __forceinline__ unsigned xb_add(unsigned* p, unsigned v) { return __hip_atomic_fetch_add(p, v, __ATOMIC_RELAXED, __HIP_MEMORY_SCOPE_AGENT); }
__device__ __forceinline__ unsigned xb_xcc_id() { return (unsigned)__builtin_amdgcn_s_getreg((3 << 11) | 20) & 0xFu; }
#define XB_SPIN(cond, bar) do { unsigned _sp = 0; while (cond) { __builtin_amdgcn_s_sleep(1); \
    if ((++_sp & 255u) == 0u) { if (xb_ld(&(bar)[XB_TMO])) break; if (_sp > XB_SPIN_CAP) { atomicAdd(&(bar)[XB_TMO], 1u); break; } } } } while (0)

struct XcdBarrier {
    unsigned* bar; unsigned x;
    volatile LAS unsigned* st;
};

__device__ __forceinline__ XcdBarrier xcd_barrier_post(unsigned* bar, volatile LAS unsigned* st) {
    XcdBarrier b; b.bar = bar; b.x = xb_xcc_id(); b.st = st;
    if (threadIdx.x == 0) (void)xb_add(&bar[XB_XCNT(b.x)], 1u);
    return b;
}
__device__ __forceinline__ void xcd_barrier_complete(unsigned* bar, unsigned x, unsigned& nloc, unsigned& nx) {
    const unsigned G = gridDim.x * gridDim.y * gridDim.z;
    unsigned sum, cnt, mine, sp = 0u;
    for (;;) {
        sum = 0u; cnt = 0u; mine = 0u;
#pragma unroll
        for (unsigned j = 0; j < 16; ++j) { const unsigned c = xb_ld(&bar[XB_XCNT(j)]); sum += c; cnt += (c > 0u) ? 1u : 0u; mine = (j == x) ? c : mine; }
        if (sum == G) break;
        __builtin_amdgcn_s_sleep(1);
        if ((++sp & 255u) == 0u) { if (xb_ld(&bar[XB_TMO])) break; if (sp > XB_SPIN_CAP) { atomicAdd(&bar[XB_TMO], 1u); break; } }
    }
    nloc = mine > 0u ? mine : 1u; nx = cnt > 0u ? cnt : 1u;
}

__device__ __forceinline__ void xcd_barrier(const XcdBarrier& b) {
    asm volatile("s_waitcnt vmcnt(0)" ::: "memory");
    __syncthreads();
    if (threadIdx.x == 0) {
        unsigned* bar = b.bar;
        __builtin_amdgcn_s_waitcnt(0);
        unsigned nloc = b.st[0], nx = b.st[1];
        if (nloc == 0u) { xcd_barrier_complete(bar, b.x, nloc, nx); b.st[0] = nloc; b.st[1] = nx; }
        const unsigned old = xb_add(&bar[XB_XSUB(b.x)], 1u);
        const unsigned gen = old / nloc;
        if (old + 1u == (gen + 1u) * nloc) {
            __builtin_amdgcn_fence(__ATOMIC_RELEASE, "agent");
            asm volatile("s_waitcnt vmcnt(0)" ::: "memory");
            const unsigned og = xb_add(&bar[XB_TOP], 1u);
            const unsigned tg = og / nx;
            if (og + 1u == (tg + 1u) * nx) xb_add(&bar[XB_TOPGEN], 1u);
            else XB_SPIN(xb_ld(&bar[XB_TOPGEN]) == tg, bar);
            __builtin_amdgcn_fence(__ATOMIC_ACQUIRE, "agent");
            xb_add(&bar[XB_XGEN(b.x)], 1u);
            asm volatile("s_waitcnt vmcnt(0)" ::: "memory");
        } else {
            XB_SPIN(xb_ld(&bar[XB_XGEN(b.x)]) == gen, bar);
            __builtin_amdgcn_fence(__ATOMIC_ACQUIRE, "agent");
            asm volatile("s_waitcnt vmcnt(0)" ::: "memory");
        }
    }
    __syncthreads();
}

__device__ __forceinline__ float wave_sum(float v) {
#pragma unroll
    for (int o = 1; o < 64; o <<= 1) v += __shfl_xor(v, o);
    return v;
}
struct CvtDesc { const float* W; const float* gain; bf16* WT; int K, N, row_off, mode; };
__device__ __forceinline__ void cvt_item(const CvtDesc& d, int item, int lane) {
    const int nblk = d.N / 64, kb = item / nblk, nb = item - kb * nblk, k0 = 64 * kb, n0 = 64 * nb;
    const int drow0 = d.mode == 0 ? d.row_off + n0 : ((n0 >> 7) * 256 + (n0 & 127) + (d.mode == 2 ? 128 : 0));
    const GAS float* src = (const GAS float*)d.W + (size_t)k0 * d.N + n0 + lane;
    float v[64];
#pragma unroll
    for (int i = 0; i < 64; ++i) v[i] = src[(size_t)i * d.N];
    if (d.gain) {
#pragma unroll
        for (int i = 0; i < 64; ++i) v[i] *= d.gain[k0 + i];
    }
    GAS v4u* dst = (GAS v4u*)(d.WT + (size_t)(drow0 + lane) * d.K + k0);
#pragma unroll
    for (int c = 0; c < 8; ++c) { v4u o; o.x = pk2(v[8 * c], v[8 * c + 1]); o.y = pk2(v[8 * c + 2], v[8 * c + 3]); o.z = pk2(v[8 * c + 4], v[8 * c + 5]); o.w = pk2(v[8 * c + 6], v[8 * c + 7]); dst[c] = o; }
}
template <int ND> __device__ __forceinline__ void cvt_run(const CvtDesc (&ds)[ND], int gw, int NGW, int lane) {
    int total = 0;
#pragma unroll
    for (int i = 0; i < ND; ++i) total += (ds[i].K / 64) * (ds[i].N / 64);
    for (int it = gw; it < total; it += NGW) { int r = __builtin_amdgcn_readfirstlane(it);
#pragma unroll
        for (int i = 0; i < ND; ++i) { const int ni = (ds[i].K / 64) * (ds[i].N / 64); if (r >= 0 && r < ni) cvt_item(ds[i], r, lane); r -= ni; } }
}
__device__ __forceinline__ void x_row_to_bf16(const float* xrow, bf16* orow, float* rstd_out, int lane) {
    const GAS f32x4* xr = (const GAS f32x4*)xrow + lane; f32x4 v[8]; float s = 0.f;
#pragma unroll
    for (int j = 0; j < 8; ++j) { v[j] = xr[64 * j]; s += (v[j][0] * v[j][0] + v[j][1] * v[j][1]) + (v[j][2] * v[j][2] + v[j][3] * v[j][3]); }
    s = wave_sum(s);
    GAS unsigned long long* o8 = (GAS unsigned long long*)orow + lane;
#pragma unroll
    for (int j = 0; j < 8; ++j) o8[64 * j] = (unsigned long long)pk2(v[j][0], v[j][1]) | ((unsigned long long)pk2(v[j][2], v[j][3]) << 32);
    if (lane == 0) *rstd_out = rsqrtf(s * (1.0f / D) + NORM_EPS);
}
__device__ __forceinline__ void sincos_d(double x, double& sn, double& cs) {
    const double n = __builtin_rint(x * 0.63661977236758134308);
    double r = __builtin_fma(-n, 1.57079632679489655800e+00, x); r = __builtin_fma(-n, 6.12323399573676603587e-17, r);
    const double z = r * r;
    const double s = r * (1.0 + z * (-1.0 / 6 + z * (1.0 / 120 + z * (-1.0 / 5040 + z * (1.0 / 362880 + z * (-1.0 / 39916800 + z * (1.0 / 6227020800.0)))))));
    const double c = 1.0 + z * (-0.5 + z * (1.0 / 24 + z * (-1.0 / 720 + z * (1.0 / 40320 + z * (-1.0 / 3628800 + z * (1.0 / 479001600 + z * (-1.0 / 87178291200.0)))))));
    const int q = (int)((long long)n & 3);
    sn = (q == 0) ? s : (q == 1) ? c : (q == 2) ? -s : -c;
    cs = (q == 0) ? c : (q == 1) ? -s : (q == 2) ? -c : s;
}
__device__ __forceinline__ void s5_pow(double lr, double li, double dt, double tau, double& pr, double& pi) {
    const double mag = exp(lr * dt * tau); double sn, cs; sincos_d(li * dt * tau, sn, cs); pr = mag * cs; pi = mag * sn;
}
struct S5In { const float *a_re, *a_im, *log_dt, *b_re, *b_im, *c_re, *c_im, *dsk; };
__device__ __forceinline__ void s5_tables_item(const S5In& in, LAS unsigned char* lds, unsigned char* ws, int g, int q, int tid) {
    LAS f32x2* pw = (LAS f32x2*)(lds + RING_OFF);
    LAS f32x2* bk = (LAS f32x2*)(lds + RING_OFF + 17408);
    LAS f32x2* cg = (LAS f32x2*)(lds + RING_OFF + 25600);
    LAS float* kt = (LAS float*)(lds + RING_OFF + 33792);
    const double dt = exp((double)in.log_dt[g]);
    for (int e = tid; e < 33 * 64; e += NWAVES * 64) { const int tau = e >> 6, p = e & 63; double pr, pi; s5_pow((double)in.a_re[g * 64 + p], (double)in.a_im[g * 64 + p], dt, (double)tau, pr, pi);
        pw[e] = (f32x2){(float)pr, (float)pi};
        if (tau == 32 && q == 0) ((f32x2*)(ws + WS_SMALL + SM_A32))[g * 64 + p] = (f32x2){(float)pr, (float)pi}; }
    if (q == 0 && tid < 64) { const int p = tid; double pr, pi; s5_pow((double)in.a_re[g * 64 + p], (double)in.a_im[g * 64 + p], dt, 1024.0, pr, pi); ((f32x2*)(ws + WS_SMALL + SM_A1024))[g * 64 + p] = (f32x2){(float)pr, (float)pi}; }
    for (int e = tid; e < 1024; e += NWAVES * 64) { const int p = e >> 4, c = e & 15; const double lr = (double)in.a_re[g * 64 + p], li = (double)in.a_im[g * 64 + p]; double ar, ai; s5_pow(lr, li, dt, 1.0, ar, ai);
        const double nr = ar - 1.0, ni = ai, den = lr * lr + li * li, kr = (nr * lr + ni * li) / den, ki = (ni * lr - nr * li) / den;
        const double br = (double)in.b_re[((size_t)g * 64 + p) * 16 + c], bi = (double)in.b_im[((size_t)g * 64 + p) * 16 + c];
        bk[e] = (f32x2){(float)(kr * br - ki * bi), (float)(kr * bi + ki * br)};
        const int c2 = e >> 6, p2 = e & 63; cg[e] = (f32x2){in.c_re[((size_t)g * 16 + c2) * 64 + p2], in.c_im[((size_t)g * 16 + c2) * 64 + p2]}; }
    LDS_WAIT(); __syncthreads();
    for (int e = tid; e < 32 * 256; e += NWAVES * 64) { const int tau = e >> 8, c2 = (e >> 4) & 15, c = e & 15; float s = 0.f;
        for (int p = 0; p < 64; ++p) { const f32x2 a = pw[tau * 64 + p], b = bk[p * 16 + c], cc = cg[c2 * 64 + p]; const float wr_ = a[0] * b[0] - a[1] * b[1], wi_ = a[0] * b[1] + a[1] * b[0]; s += cc[0] * wr_ - cc[1] * wi_; }
        if (tau == 0 && c2 == c) s += in.dsk[g * 16 + c];
        kt[e] = s; }
    LDS_WAIT(); __syncthreads();
    bf16* tm = (bf16*)(ws + WS_TM) + (size_t)g * 768 * 512;
    for (int e = tid; e < 192 * 64; e += NWAVES * 64) { const int rho = 192 * q + (e >> 6), kc = (e & 63) * 8, s = kc >> 4, c0 = kc & 15; float v[8];
#pragma unroll
        for (int j = 0; j < 8; ++j) { const int c = c0 + j; float x = 0.f;
            if (rho < 512) { const int t = rho >> 4, c2 = rho & 15; if (s <= t) x = kt[((t - s) * 16 + c2) * 16 + c]; }
            else if (rho < 640) { const int p = (rho - 512) & 63; const f32x2 a = pw[(31 - s) * 64 + p], b = bk[p * 16 + c]; x = rho < 576 ? (a[0] * b[0] - a[1] * b[1]) : (a[0] * b[1] + a[1] * b[0]); }
            v[j] = x; }
        v4u o; o.x = pk2(v[0], v[1]); o.y = pk2(v[2], v[3]); o.z = pk2(v[4], v[5]); o.w = pk2(v[6], v[7]);
        *(GAS v4u*)(tm + (size_t)rho * 512 + kc) = o; }
    bf16* gm = (bf16*)(ws + WS_GM) + (size_t)g * 512 * 256;
    for (int e = tid; e < 128 * 32; e += NWAVES * 64) { const int rho = 128 * q + (e >> 5), kc = (e & 31) * 8, t = rho >> 4, c2 = rho & 15; float v[8];
#pragma unroll
        for (int j = 0; j < 8; ++j) { const int k = kc + j; float x = 0.f;
            if (k < 128) { const int p = k & 63; const f32x2 a = pw[(t + 1) * 64 + p], cc = cg[c2 * 64 + p]; x = k < 64 ? (cc[0] * a[0] - cc[1] * a[1]) : -(cc[0] * a[1] + cc[1] * a[0]); }
            v[j] = x; }
        v4u o; o.x = pk2(v[0], v[1]); o.y = pk2(v[2], v[3]); o.z = pk2(v[4], v[5]); o.w = pk2(v[6], v[7]);
        *(GAS v4u*)(gm + (size_t)rho * 256 + kc) = o; }
    LDS_WAIT(); __syncthreads();
}
__device__ __forceinline__ void s5_scan(LAS unsigned char* lds, const unsigned char* ws, bf16* xin, int g, int wave, int lane) {
    const f32x2 a32 = ((const f32x2*)(ws + WS_SMALL + SM_A32))[g * 64 + lane], a1k = ((const f32x2*)(ws + WS_SMALL + SM_A1024))[g * 64 + lane];
    const float* eg = (const float*)(ws + WS_EST) + ((size_t)g * 256 + 32 * wave) * 128;
    float er[32], ei[32];
#pragma unroll
    for (int i = 0; i < 32; ++i) { er[i] = eg[i * 128 + lane]; ei[i] = eg[i * 128 + 64 + lane]; }
    float sr = 0.f, si = 0.f;
#pragma unroll
    for (int i = 0; i < 32; ++i) { const float nr = a32[0] * sr - a32[1] * si + er[i], ni = a32[0] * si + a32[1] * sr + ei[i]; sr = nr; si = ni; }
    LAS f32x2* seg = (LAS f32x2*)(lds + RING_OFF);
    seg[wave * 64 + lane] = (f32x2){sr, si};
    LDS_WAIT(); __syncthreads();
    sr = 0.f; si = 0.f;
    for (int w = 0; w < wave; ++w) { const f32x2 e = seg[w * 64 + lane]; const float nr = a1k[0] * sr - a1k[1] * si + e[0], ni = a1k[0] * si + a1k[1] * sr + e[1]; sr = nr; si = ni; }
    bf16* xo = xin + (size_t)(32 * wave) * 256;
#pragma unroll
    for (int i = 0; i < 32; ++i) { xo[i * 256 + lane] = (bf16)f2bf(sr); xo[i * 256 + 64 + lane] = (bf16)f2bf(si); xo[i * 256 + 128 + lane] = 0; xo[i * 256 + 192 + lane] = 0;
        const float nr = a32[0] * sr - a32[1] * si + er[i], ni = a32[0] * si + a32[1] * sr + ei[i]; sr = nr; si = ni; }
    VM_WAIT(); LDS_WAIT(); __syncthreads();
}
__device__ __forceinline__ void sgu_item(LAS unsigned char* lds, const unsigned char* ws, const float* ln_g, const float* ln_b, const float* b_s, int n, int h, int tid, int wave, int lane) {
    constexpr int RS = 136;
    LAS bf16* vT = (LAS bf16*)(lds + RING_OFF);
    LAS float* mu = (LAS float*)(lds + RING_OFF + 128 * RS * 2);
    LAS float* rsd = mu + 128;
    const int t0 = 128 * n, c0 = 128 * h;
    if (tid < 128) { const f32x4* p = (const f32x4*)((const float*)(ws + WS_LNST) + (size_t)(t0 + tid) * 32); float s1 = 0.f, s2 = 0.f;
#pragma unroll
        for (int i = 0; i < 8; ++i) { const f32x4 a = p[i]; s1 += a[0] + a[2]; s2 += a[1] + a[3]; }
        const float m_ = s1 * (1.0f / 1024.0f), var = s2 * (1.0f / 1024.0f) - m_ * m_; mu[tid] = m_; rsd[tid] = rsqrtf(fmaxf(var, 0.f) + NORM_EPS); }
    LDS_WAIT(); __syncthreads();
    { const int cgp = tid & 15; f32x4 g0 = *(const f32x4*)(ln_g + c0 + 8 * cgp), g1 = *(const f32x4*)(ln_g + c0 + 8 * cgp + 4), b0 = *(const f32x4*)(ln_b + c0 + 8 * cgp), b1 = *(const f32x4*)(ln_b + c0 + 8 * cgp + 4);
#pragma unroll
        for (int i = 0; i < 4; ++i) { const int s = (tid >> 4) + 32 * i; const v4u w = *(const GAS v4u*)((const bf16*)(ws + WS_VB) + (size_t)(t0 + s) * 1024 + c0 + 8 * cgp);
            const float m_ = mu[s], r_ = rsd[s]; float x[8] = {pg8::bf_lo(w.x), pg8::bf_hi(w.x), pg8::bf_lo(w.y), pg8::bf_hi(w.y), pg8::bf_lo(w.z), pg8::bf_hi(w.z), pg8::bf_lo(w.w), pg8::bf_hi(w.w)};
#pragma unroll
            for (int j = 0; j < 8; ++j) { const float gg = j < 4 ? g0[j & 3] : g1[j & 3], bb = j < 4 ? b0[j & 3] : b1[j & 3]; vT[(8 * cgp + j) * RS + s] = (bf16)f2bf((x[j] - m_) * r_ * gg + bb); } } }
    LDS_WAIT(); __syncthreads();
    const bf16* wsb = (const bf16*)(ws + WS_SMALL + SM_WSB) + (size_t)h * 128 * 128;
    const int fr = lane & 15, fq = lane >> 4, t = 16 * wave + fr;
    bf16x8 bfr[4];
#pragma unroll
    for (int kk = 0; kk < 4; ++kk) bfr[kk] = *(const GAS bf16x8*)(wsb + (size_t)t * 128 + kk * 32 + 8 * fq);
    f32x4 acc[8];
#pragma unroll
    for (int ct = 0; ct < 8; ++ct) { acc[ct] = (f32x4){0.f, 0.f, 0.f, 0.f};
#pragma unroll
        for (int kk = 0; kk < 4; ++kk) { const bf16x8 af = *(const LAS bf16x8*)(vT + (16 * ct + fr) * RS + kk * 32 + 8 * fq); acc[ct] = __builtin_amdgcn_mfma_f32_16x16x32_bf16(af, bfr[kk], acc[ct], 0, 0, 0); } }
    const float bias = b_s[h * 128 + t]; const size_t orow = (size_t)(t0 + t) * 1024 + c0;
#pragma unroll
    for (int ct = 0; ct < 8; ++ct) { const int c = 16 * ct + 4 * fq; const pg8::u32x2 uw = *(const GAS pg8::u32x2*)((const bf16*)(ws + WS_UB) + orow + c);
        pg8::u32x2 o; o.x = pg8::cvt_pk_bf16(pg8::bf_lo(uw.x) * (acc[ct][0] + bias), pg8::bf_hi(uw.x) * (acc[ct][1] + bias)); o.y = pg8::cvt_pk_bf16(pg8::bf_lo(uw.y) * (acc[ct][2] + bias), pg8::bf_hi(uw.y) * (acc[ct][3] + bias));
        *(GAS pg8::u32x2*)((bf16*)(ws + WS_YB) + orow + c) = o; }
    LDS_WAIT(); __syncthreads();
}
__device__ __forceinline__ void final_row(float* xrow, const float* ssrow, const float* fn, int lane) {
    float s = lane < 32 ? ssrow[lane] : 0.f; s = wave_sum(s); const float rstd = rsqrtf(s * (1.0f / D) + NORM_EPS);
    GAS f32x4* xr = (GAS f32x4*)xrow + lane; const GAS f32x4* gr = (const GAS f32x4*)fn + lane;
#pragma unroll
    for (int j = 0; j < 8; ++j) { const f32x4 v = xr[64 * j] * rstd * gr[64 * j]; xr[64 * j] = v; }
}

struct Args { const float* in[31]; float* out; unsigned char* ws; int ph_lo, ph_hi; };
enum { I_X = 0, I_F1N, I_F1G, I_F1U, I_F1D, I_MIXN, I_WIN, I_ARE, I_AIM, I_LDT, I_BRE, I_BIM, I_CRE, I_CIM, I_DSK, I_WGLU, I_BGLU, I_LNG, I_LNB, I_WS, I_BS, I_WBA, I_WBB, I_WG, I_BG, I_WOUT, I_F2N, I_F2G, I_F2U, I_F2D, I_FN };
typedef const __attribute__((address_space(4))) Args* KArgsP;
__device__ __forceinline__ KArgsP kargs() { KArgsP p = (KArgsP)__builtin_amdgcn_kernarg_segment_ptr(); asm volatile("" : "+s"(p)); return p; }
#define AIN(i) (kargs()->in[i])
__global__ void __launch_bounds__(NWAVES * 64, 2) mk_fwd(Args args_unused) {
    extern __shared__ __attribute__((aligned(16))) unsigned char lds_raw[];
    LAS unsigned char* lds = (LAS unsigned char*)lds_raw;
    const int tid = threadIdx.x, lane = tid & 63, wave = __builtin_amdgcn_readfirstlane(tid >> 6);
    const int G = gridDim.x, bx = blockIdx.x;
    const int vcu = (G % 8 == 0) ? (bx % 8) * (G / 8) + bx / 8 : bx;
    unsigned char* const ws = kargs()->ws;
    for (int u = tid; u < (LDS_BYTES - LDSCTL_OFF) / 4; u += NWAVES * 64) ((LAS unsigned*)(lds + LDSCTL_OFF))[u] = 0u;
    __syncthreads();
    XcdBarrier bar; bar.bar = (unsigned*)(ws + WS_CTL) + CW_BAR; bar.x = 0; bar.st = nullptr;
    if (N_LAUNCHES == 1) bar = xcd_barrier_post((unsigned*)(ws + WS_CTL) + CW_BAR, (volatile LAS unsigned*)(lds + MISC_OFF) + 8);
    const int lo = kargs()->ph_lo, hi = kargs()->ph_hi;
#ifndef PH_MASK
#define PH_MASK 0xfff
#endif
#define IN(k) (((PH_MASK >> (k)) & 1) && lo <= (k) && (k) < hi)
#ifndef REP_MASK
#define REP_MASK 0
#endif
#define REPS(k) for (int rep_ = 0; rep_ < 1 + ((REP_MASK >> (k)) & 1); ++rep_)
#define SEAM(k) do { if (IN(k) && IN((k) + 1)) xcd_barrier(bar); } while (0)
    const int gw = vcu * NWAVES + wave, NGW = G * NWAVES;
    bf16* const XB = (bf16*)(ws + WS_XB); bf16* const ACT = (bf16*)(ws + WS_ACT); float* const SS = (float*)(ws + WS_SS);
    LAS unsigned char* ring = lds + RING_OFF;

    if (IN(0)) REPS(0) {
        const CvtDesc ds[8] = {
            {AIN(I_F1G), AIN(I_F1N), (bf16*)(ws + WS_W1A), D, FF, 0, 1}, {AIN(I_F1U), AIN(I_F1N), (bf16*)(ws + WS_W1A), D, FF, 0, 2},
            {AIN(I_F1D), nullptr, (bf16*)(ws + WS_W2A), FF, D, 0, 0},
            {AIN(I_WIN), AIN(I_MIXN), (bf16*)(ws + WS_WMIX), D, 3072, 0, 0}, {AIN(I_WG), AIN(I_MIXN), (bf16*)(ws + WS_WMIX), D, 4096, 3072, 0},
            {AIN(I_WGLU), nullptr, (bf16*)(ws + WS_WGLU), SW, SW, 0, 0},
            {AIN(I_WBA), nullptr, (bf16*)(ws + WS_WA), SW, D, 0, 0}, {AIN(I_WBB), nullptr, (bf16*)(ws + WS_WB), SW, D, 0, 0} };
        cvt_run<8>(ds, gw, NGW, lane);
        const CvtDesc d2[1] = { {AIN(I_WOUT), nullptr, (bf16*)(ws + WS_WOUT), D, D, 0, 0} };
        cvt_run<1>(d2, gw, NGW, lane);
        for (int m = gw; m < M; m += NGW) x_row_to_bf16(AIN(I_X) + (size_t)m * D, XB + (size_t)m * D, (float*)(ws + WS_SMALL + SM_RSTD0) + m, lane);
        { const float* w_s = AIN(I_WS); bf16* wsb = (bf16*)(ws + WS_SMALL + SM_WSB);
          for (int e = bx * (NWAVES * 64) + tid; e < 8 * 128 * 128; e += G * NWAVES * 64) { const int t = (e >> 7) & 127, s = e & 127; wsb[e] = (bf16)f2bf(((t >> 6) >= (s >> 6)) ? w_s[e] : 0.f); } }
        __syncthreads();
        const S5In s5{AIN(I_ARE), AIN(I_AIM), AIN(I_LDT), AIN(I_BRE), AIN(I_BIM), AIN(I_CRE), AIN(I_CIM), AIN(I_DSK)};
        for (int it = bx; it < 256; it += G) s5_tables_item(s5, lds, ws, it & 63, it >> 6, tid);
    }
    SEAM(0);
    if (IN(1)) REPS(1) {
        pg8::Gemm g{XB, (const bf16*)(ws + WS_W1A), M, 2 * FF, D}; pg8::StaticOrder S; S.init(M, 2 * FF, G, bx);
        pg8::EpiFfnUp<0> E{ACT, FF, (const float*)(ws + WS_SMALL + SM_RSTD0)};
        pg8::gemm_phase<pg8::EpiFfnUp<0>, pg8::StaticOrder, true, true>(ring, g, S, E);
    }
    SEAM(1);
    if (IN(2)) REPS(2) {
        pg8::Gemm g{ACT, (const bf16*)(ws + WS_W2A), M, D, FF}; pg8::StaticOrder S; S.init(M, D, G, bx);
        pg8::EpiResid<true> E{AIN(I_X), kargs()->out, XB, SS, 0.5f};
        pg8::gemm_phase<pg8::EpiResid<true>, pg8::StaticOrder, true, true>(ring, g, S, E);
    }
    SEAM(2);
    if (IN(3)) REPS(3) {
        pg8::Gemm g{XB, (const bf16*)(ws + WS_WMIX), M, NMIX, D}; pg8::StaticOrder S; S.init(M, NMIX, G, bx);
        pg8::EpiMixIn E{(bf16*)(ws + WS_UA), (bf16*)(ws + WS_UB), (bf16*)(ws + WS_VB), (bf16*)(ws + WS_GT), (float*)(ws + WS_LNST), SS, AIN(I_BG)};
        pg8::gemm_phase<pg8::EpiMixIn, pg8::StaticOrder, true, true>(ring, g, S, E);
    }
    SEAM(3);
    if (IN(4)) REPS(4) {
        pg8::Gemm g{(const bf16*)(ws + WS_UA), (const bf16*)(ws + WS_TM), S5G * 256, 768 * S5G, 512}; pg8::BatchOrder S{192, 3, G, bx, false};
        pg8::EpiS5Loc E{(float*)(ws + WS_YLOC), (float*)(ws + WS_EST)};
        pg8::gemm_phase<pg8::EpiS5Loc, pg8::BatchOrder, true, true>(ring, g, S, E);
        __syncthreads();
        if (G == 256) {
            if (bx >= 192) for (int i = 0; i < 4; ++i) { const int it = (bx - 192) * 4 + i; sgu_item(lds, ws, AIN(I_LNG), AIN(I_LNB), AIN(I_BS), it >> 3, it & 7, tid, wave, lane); }
            { const int it = 256 + bx; sgu_item(lds, ws, AIN(I_LNG), AIN(I_LNB), AIN(I_BS), it >> 3, it & 7, tid, wave, lane); }
        } else { for (int it = bx; it < 512; it += G) sgu_item(lds, ws, AIN(I_LNG), AIN(I_LNB), AIN(I_BS), it >> 3, it & 7, tid, wave, lane); }
    }
    SEAM(4);
    if (IN(5)) REPS(5) {
        for (int L = bx; L < 128; L += G) s5_scan(lds, ws, (bf16*)(ws + WS_XIN) + (size_t)L * 256 * 256, L >> 1, wave, lane);
        pg8::Gemm g{(const bf16*)(ws + WS_XIN), (const bf16*)(ws + WS_GM), 128 * 256, 512 * S5G, 256}; pg8::BatchOrder S{128, 2, G, bx, true};
        pg8::EpiS5Out E{(const float*)(ws + WS_YLOC), (bf16*)(ws + WS_YG)};
        pg8::gemm_phase<pg8::EpiS5Out, pg8::BatchOrder, true, true>(ring, g, S, E);
    }
    SEAM(5);
    if (IN(6)) REPS(6) {
        pg8::Gemm g{(const bf16*)(ws + WS_YG), (const bf16*)(ws + WS_WGLU), M, SW, SW}; pg8::StaticOrder S; S.init(M, SW, G, bx);
        pg8::EpiGlu E{(const bf16*)(ws + WS_YG), (bf16*)(ws + WS_YA), AIN(I_BGLU)};
        pg8::gemm_phase<pg8::EpiGlu, pg8::StaticOrder, true, true>(ring, g, S, E);
    }
    SEAM(6);
    if (IN(7)) REPS(7) {
        { pg8::Gemm g{(const bf16*)(ws + WS_YA), (const bf16*)(ws + WS_WA), M, D, SW}; pg8::StaticOrder S; S.init(M, D, G, bx);
          pg8::EpiBranch<false> E{(const bf16*)(ws + WS_GT), (bf16*)(ws + WS_MG)};
          pg8::gemm_phase<pg8::EpiBranch<false>, pg8::StaticOrder, true, true>(ring, g, S, E); }
        __syncthreads();
        { pg8::Gemm g{(const bf16*)(ws + WS_YB), (const bf16*)(ws + WS_WB), M, D, SW}; pg8::StaticOrder S; S.init(M, D, G, bx);
          pg8::EpiBranch<true> E{(const bf16*)(ws + WS_GT) + 2048, (bf16*)(ws + WS_MG)};
          pg8::gemm_phase<pg8::EpiBranch<true>, pg8::StaticOrder, true, true>(ring, g, S, E); }
    }
    SEAM(7);
    if (IN(8)) REPS(8) {
        const CvtDesc ds[3] = { {AIN(I_F2G), AIN(I_F2N), (bf16*)(ws + WS_W1B), D, FF, 0, 1}, {AIN(I_F2U), AIN(I_F2N), (bf16*)(ws + WS_W1B), D, FF, 0, 2}, {AIN(I_F2D), nullptr, (bf16*)(ws + WS_W2B), FF, D, 0, 0} };
        cvt_run<3>(ds, gw, NGW, lane);
        __syncthreads();
        pg8::Gemm g{(const bf16*)(ws + WS_MG), (const bf16*)(ws + WS_WOUT), M, D, D}; pg8::StaticOrder S; S.init(M, D, G, bx);
        pg8::EpiResid<true> E{kargs()->out, kargs()->out, XB, SS, 1.0f};
        pg8::gemm_phase<pg8::EpiResid<true>, pg8::StaticOrder, true, true>(ring, g, S, E);
    }
    SEAM(8);
    if (IN(9)) REPS(9) {
        pg8::Gemm g{XB, (const bf16*)(ws + WS_W1B), M, 2 * FF, D}; pg8::StaticOrder S; S.init(M, 2 * FF, G, bx);
        pg8::EpiFfnUp<1> E{ACT, FF, SS};
        pg8::gemm_phase<pg8::EpiFfnUp<1>, pg8::StaticOrder, true, true>(ring, g, S, E);
    }
    SEAM(9);
    if (IN(10)) REPS(10) {
        pg8::Gemm g{ACT, (const bf16*)(ws + WS_W2B), M, D, FF}; pg8::StaticOrder S; S.init(M, D, G, bx);
        pg8::EpiResid<false> E{kargs()->out, kargs()->out, nullptr, SS, 0.5f};
        pg8::gemm_phase<pg8::EpiResid<false>, pg8::StaticOrder, true, true>(ring, g, S, E);
    }
    SEAM(10);
    if (IN(11)) REPS(11) { for (int m = gw; m < M; m += NGW) final_row(kargs()->out + (size_t)m * D, SS + (size_t)m * 32, AIN(I_FN), lane); }
#undef IN
#undef SEAM
}

extern "C" void kernel_launch(void* const* d_in, const int* in_sizes, int n_in, void* d_out, int out_size, void* d_ws, size_t ws_size, hipStream_t stream) {
    static int grid = 0;
    if (grid == 0) {
        if (n_in != 31 || in_sizes[0] != M * D || out_size != M * D || ws_size < WS_END) { fprintf(stderr, "kernel_launch: unexpected shapes: n_in %d in0 %d out %d ws %zu (need %zu)\n", n_in, n_in > 0 ? in_sizes[0] : -1, out_size, ws_size, (size_t)WS_END); grid = -1; return; }
        int dev = 0, cus = 0, per_cu = 0;
        if (hipGetDevice(&dev) != hipSuccess || hipDeviceGetAttribute(&cus, hipDeviceAttributeMultiprocessorCount, dev) != hipSuccess) { fprintf(stderr, "kernel_launch: device query failed\n"); grid = -1; return; }
        if (hipFuncSetAttribute((const void*)mk_fwd, hipFuncAttributeMaxDynamicSharedMemorySize, LDS_BYTES) != hipSuccess) { fprintf(stderr, "kernel_launch: hipFuncSetAttribute failed\n"); grid = -1; return; }
        if (hipOccupancyMaxActiveBlocksPerMultiprocessor(&per_cu, (const void*)mk_fwd, NWAVES * 64, LDS_BYTES) != hipSuccess || per_cu < 1) fprintf(stderr, "kernel_launch: occupancy query reports %d blocks per CU\n", per_cu);
        (void)hipGetLastError();
        grid = cus;
    }
    if (grid < 0) return;
    if (hipMemsetAsync((char*)d_ws + WS_CTL, 0, CTL_ZERO_BYTES, stream) != hipSuccess) { fprintf(stderr, "kernel_launch: memset failed\n"); return; }
    Args a{};
    for (int i = 0; i < 31; ++i) a.in[i] = (const float*)d_in[i];
    a.out = (float*)d_out; a.ws = (unsigned char*)d_ws;
    for (int li = 0; li < N_LAUNCHES; ++li) {
        a.ph_lo = (N_LAUNCHES == 1) ? 0 : li; a.ph_hi = (N_LAUNCHES == 1) ? PER_PHASE : li + 1;
        hipLaunchKernelGGL(mk_fwd, dim3(grid), dim3(NWAVES * 64), LDS_BYTES, stream, a);
        const hipError_t le = hipPeekAtLastError();
        if (le != hipSuccess) { fprintf(stderr, "kernel_launch: launch %d failed: %s\n", li, hipGetErrorName(le)); break; }
    }
}
```

```cpp
#include <hip/hip_runtime.h>
#include <cstdio>
#include <cstdint>
#ifndef MK_N_LAUNCHES
#define MK_N_LAUNCHES 1
#endif
namespace pg8 {
#define PG8_LAS __attribute__((address_space(3)))
typedef unsigned short bf16_t;
typedef short bf16x8 __attribute__((ext_vector_type(8)));
typedef float f32x4 __attribute__((ext_vector_type(4)));
typedef unsigned u32x4 __attribute__((ext_vector_type(4)));
constexpr int BM = 256, BK = 64, HALF = 128, HTB = HALF * BK * 2  , STAGE_BYTES = 8 * HTB, NXCD = 8, WGM = 8;

__host__ __device__ __forceinline__ int lds_byte(int r, int c) { const int st = (r >> 4) * 2 + (c >> 5), rr = r & 15, cc = c & 31, ob = rr * 64 + cc * 2; return st * 1024 + (ob ^ (((ob >> 9) & 1) << 5)); }
__host__ __device__ __forceinline__ void stage_rc(int b, int& R, int& C) { const int st = b / 1024, sb = b % 1024, swz = sb ^ (((sb >> 9) & 1) << 5); R = (st >> 1) * 16 + swz / 64; C = (st & 1) * 32 + (swz % 64) / 2; }
__host__ __device__ __forceinline__ int perm32(int rho) { const int n = rho >> 4, i = rho & 15; return 8 * (i >> 2) + 4 * n + (i & 3); }

struct Unit { int pm, pn; };
struct Gemm { const bf16_t* A; const bf16_t* Bt; int M, N, K; };

struct StaticOrder {
    int nM, nN, nwg, G, c;
    __host__ __device__ void init(int M, int N, int G_, int c_) { nM = M / BM; nN = N / BM; nwg = nM * nN; G = G_; c = c_; }
    __host__ __device__ bool next(int i, Unit& u) const {
        const long L = (long)i * G + c; if (L >= nwg) return false;
        int wgid = (int)L; { const int q = nwg / NXCD, r = nwg % NXCD, xcd = wgid % NXCD, off = wgid / NXCD; wgid = (xcd < r ? xcd * (q + 1) : r * (q + 1) + (xcd - r) * q) + off; }
        const int nig = WGM * nN, gid = wgid / nig, fm = gid * WGM, gsz = (nM - fm) < WGM ? (nM - fm) : WGM;
        u.pm = fm + ((wgid % nig) % gsz); u.pn = (wgid % nig) / gsz; return true;
    }
    __device__ __forceinline__ void a_ready(const Unit&) const {}
    __device__ __forceinline__ void done(const Unit&) const {}
};

__device__ __forceinline__ unsigned cvt_pk_bf16(float lo, float hi) { unsigned r; asm volatile("v_cvt_pk_bf16_f32 %0, %1, %2" : "=v"(r) : "v"(lo), "v"(hi)); return r; }

typedef float f32x2 __attribute__((ext_vector_type(2)));
typedef unsigned u32x2 __attribute__((ext_vector_type(2)));
__device__ __forceinline__ float sigm(float x) { return __builtin_amdgcn_rcpf(1.0f + __builtin_amdgcn_exp2f(-1.4426950408889634f * x)); }
__device__ __forceinline__ float silu_f(float x) { return x * sigm(x); }
__device__ __forceinline__ float gelu_f(float x) { return x * sigm(1.5957691216057308f * (x + 0.044715f * x * x * x)); }
__device__ __forceinline__ float bf_lo(unsigned w) { return __uint_as_float(w << 16); }
__device__ __forceinline__ float bf_hi(unsigned w) { return __uint_as_float(w & 0xffff0000u); }
__device__ __forceinline__ u32x4 pack8(const f32x4 a, const f32x4 b) { u32x4 w; w.x = cvt_pk_bf16(a[0], a[1]); w.y = cvt_pk_bf16(a[2], a[3]); w.z = cvt_pk_bf16(b[0], b[1]); w.w = cvt_pk_bf16(b[2], b[3]); return w; }
__device__ __forceinline__ void unpack8(const u32x4 w, f32x4& a, f32x4& b) { a = (f32x4){bf_lo(w.x), bf_hi(w.x), bf_lo(w.y), bf_hi(w.y)}; b = (f32x4){bf_lo(w.z), bf_hi(w.z), bf_lo(w.w), bf_hi(w.w)}; }
constexpr float NORM_EPS = 1e-6f;
constexpr int DM = 2048;
template <int RMODE> __device__ __forceinline__ float row_rstd(const float* rs, int r, int fq) {
    if (RMODE == 0) return rs[r];
    const f32x4* p = (const f32x4*)(rs + (size_t)r * 32 + 8 * fq); const f32x4 a = p[0], b = p[1];
    float s = ((a[0] + a[1]) + (a[2] + a[3])) + ((b[0] + b[1]) + (b[2] + b[3]));
    s += __shfl_xor(s, 16); s += __shfl_xor(s, 32);
    return rsqrtf(s * (1.0f / DM) + NORM_EPS);
}
template <int RMODE> struct EpiFfnUp {
    static constexpr bool PERM = true, AFTER_DRAIN = false;
    bf16_t* act; int ldc; const float* rs;
    __device__ __forceinline__ void operator()(const f32x4 (&acc)[2][2][4][2], const Unit& u, int wr, int wc, int fr, int fq) const {
        asm volatile("" : "+v"(fr), "+v"(fq));
        const int row0 = u.pm * BM + wr * 64 + fr, col0 = u.pn * HALF + wc * 32 + 8 * fq;
#pragma unroll
        for (int ai = 0; ai < 2; ++ai)
#pragma unroll
            for (int m = 0; m < 4; ++m) { const int r = row0 + ai * HALF + m * 16; const float rstd = row_rstd<RMODE>(rs, r, fq);
                f32x4 o0, o1;
#pragma unroll
                for (int j = 0; j < 4; ++j) { o0[j] = silu_f(acc[ai][0][m][0][j] * rstd) * (acc[ai][1][m][0][j] * rstd); o1[j] = silu_f(acc[ai][0][m][1][j] * rstd) * (acc[ai][1][m][1][j] * rstd); }
                *(u32x4*)(act + (size_t)r * ldc + col0) = pack8(o0, o1); }
    }
};
template <bool WB16> struct EpiResid {
    static constexpr bool PERM = true, AFTER_DRAIN = false;
    const float* xold; float* xnew; bf16_t* xb; float* ss; float scale;
    __device__ __forceinline__ void operator()(const f32x4 (&acc)[2][2][4][2], const Unit& u, int wr, int wc, int fr, int fq) const {
        asm volatile("" : "+v"(fr), "+v"(fq));
        const int row0 = u.pm * BM + wr * 64 + fr, col0 = u.pn * BM + wc * 32 + 8 * fq;
#pragma unroll
        for (int ai = 0; ai < 2; ++ai)
#pragma unroll
            for (int m = 0; m < 4; ++m) { const int r = row0 + ai * HALF + m * 16; float q = 0.f;
#pragma unroll
                for (int bj = 0; bj < 2; ++bj) { const size_t off = (size_t)r * DM + col0 + bj * HALF;
                    const f32x4 v0 = *(const f32x4*)(xold + off) + acc[ai][bj][m][0] * scale, v1 = *(const f32x4*)(xold + off + 4) + acc[ai][bj][m][1] * scale;
                    *(f32x4*)(xnew + off) = v0; *(f32x4*)(xnew + off + 4) = v1;
                    q += ((v0[0] * v0[0] + v0[1] * v0[1]) + (v0[2] * v0[2] + v0[3] * v0[3])) + ((v1[0] * v1[0] + v1[1] * v1[1]) + (v1[2] * v1[2] + v1[3] * v1[3]));
                    if (WB16) *(u32x4*)(xb + off) = pack8(v0, v1); }
                q += __shfl_xor(q, 16); q += __shfl_xor(q, 32);
                if (fq == 0) ss[(size_t)r * 32 + u.pn * 4 + wc] = q; }
    }
};
struct EpiMixIn {
    static constexpr bool PERM = true, AFTER_DRAIN = false;
    bf16_t *ua, *ub, *vb, *gt; float* lnst; const float* rs; const float* bgate;
    __device__ __forceinline__ void operator()(const f32x4 (&acc)[2][2][4][2], const Unit& u, int wr, int wc, int fr, int fq) const {
        asm volatile("" : "+v"(fr), "+v"(fq));
        const int row0 = u.pm * BM + wr * 64 + fr, colw = wc * 32 + 8 * fq;
        const int kind = u.pn < 4 ? 0 : (u.pn < 8 ? 1 : (u.pn < 12 ? 2 : 3));
#pragma unroll
        for (int ai = 0; ai < 2; ++ai)
#pragma unroll
            for (int m = 0; m < 4; ++m) { const int r = row0 + ai * HALF + m * 16; const float rstd = row_rstd<1>(rs, r, fq);
                if (kind == 0) {
#pragma unroll
                    for (int bj = 0; bj < 2; ++bj) { const int c = u.pn * BM + bj * HALF + colw;
                        *(u32x4*)(ua + ((size_t)(c >> 4) * 8192 + r) * 16 + (c & 15)) = pack8(acc[ai][bj][m][0] * rstd, acc[ai][bj][m][1] * rstd); }
                } else if (kind == 1) {
#pragma unroll
                    for (int bj = 0; bj < 2; ++bj) { const int c = (u.pn - 4) * BM + bj * HALF + colw; f32x4 o0, o1;
#pragma unroll
                        for (int j = 0; j < 4; ++j) { o0[j] = gelu_f(acc[ai][bj][m][0][j] * rstd); o1[j] = gelu_f(acc[ai][bj][m][1][j] * rstd); }
                        *(u32x4*)(ub + (size_t)r * 1024 + c) = pack8(o0, o1); }
                } else if (kind == 2) { float s1 = 0.f, s2 = 0.f;
#pragma unroll
                    for (int bj = 0; bj < 2; ++bj) { const int c = (u.pn - 8) * BM + bj * HALF + colw; f32x4 o0, o1;
#pragma unroll
                        for (int j = 0; j < 4; ++j) { o0[j] = gelu_f(acc[ai][bj][m][0][j] * rstd); o1[j] = gelu_f(acc[ai][bj][m][1][j] * rstd); s1 += o0[j] + o1[j]; s2 += o0[j] * o0[j] + o1[j] * o1[j]; }
                        *(u32x4*)(vb + (size_t)r * 1024 + c) = pack8(o0, o1); }
                    s1 += __shfl_xor(s1, 16); s1 += __shfl_xor(s1, 32); s2 += __shfl_xor(s2, 16); s2 += __shfl_xor(s2, 32);
                    if (fq == 0) *(f32x2*)(lnst + ((size_t)r * 16 + (u.pn - 8) * 4 + wc) * 2) = (f32x2){s1, s2};
                } else {
#pragma unroll
                    for (int bj = 0; bj < 2; ++bj) { const int c = (u.pn - 12) * BM + bj * HALF + colw; const f32x4 b0 = *(const f32x4*)(bgate + c), b1 = *(const f32x4*)(bgate + c + 4); f32x4 o0, o1;
#pragma unroll
                        for (int j = 0; j < 4; ++j) { o0[j] = sigm(acc[ai][bj][m][0][j] * rstd + b0[j]); o1[j] = sigm(acc[ai][bj][m][1][j] * rstd + b1[j]); }
                        *(u32x4*)(gt + (size_t)r * 4096 + c) = pack8(o0, o1); }
                } }
    }
};
struct EpiS5Loc {
    static constexpr bool PERM = true, AFTER_DRAIN = false;
    float* yloc; float* est;
    __device__ __forceinline__ void operator()(const f32x4 (&acc)[2][2][4][2], const Unit& u, int wr, int wc, int fr, int fq) const {
        asm volatile("" : "+v"(fr), "+v"(fq));
        const int g = u.pn / 3, j3 = u.pn - 3 * g, row0 = wr * 64 + fr, colw = wc * 32 + 8 * fq;
#pragma unroll
        for (int ai = 0; ai < 2; ++ai)
#pragma unroll
            for (int m = 0; m < 4; ++m) { const int n = row0 + ai * HALF + m * 16;
                if (j3 < 2) {
#pragma unroll
                    for (int bj = 0; bj < 2; ++bj) { float* p = yloc + ((size_t)g * 256 + n) * 512 + j3 * BM + bj * HALF + colw; *(f32x4*)p = acc[ai][bj][m][0]; *(f32x4*)(p + 4) = acc[ai][bj][m][1]; }
                } else { float* p = est + ((size_t)g * 256 + n) * 128 + colw; *(f32x4*)p = acc[ai][0][m][0]; *(f32x4*)(p + 4) = acc[ai][0][m][1]; } }
    }
};
struct EpiS5Out {
    static constexpr bool PERM = true, AFTER_DRAIN = false;
    const float* yloc; bf16_t* yg;
    __device__ __forceinline__ void operator()(const f32x4 (&acc)[2][2][4][2], const Unit& u, int wr, int wc, int fr, int fq) const {
        asm volatile("" : "+v"(fr), "+v"(fq));
        const int g = u.pn >> 1, j2 = u.pn & 1, row0 = wr * 64 + fr, colw = wc * 32 + 8 * fq;
#pragma unroll
        for (int ai = 0; ai < 2; ++ai)
#pragma unroll
            for (int m = 0; m < 4; ++m) { const int n = row0 + ai * HALF + m * 16;
#pragma unroll
                for (int bj = 0; bj < 2; ++bj) { const int col = j2 * BM + bj * HALF + colw; const float* p = yloc + ((size_t)g * 256 + n) * 512 + col;
                    const f32x4 y0 = *(const f32x4*)p + acc[ai][bj][m][0], y1 = *(const f32x4*)(p + 4) + acc[ai][bj][m][1]; f32x4 o0, o1;
#pragma unroll
                    for (int j = 0; j < 4; ++j) { o0[j] = gelu_f(y0[j]); o1[j] = gelu_f(y1[j]); }
                    *(u32x4*)(yg + ((size_t)(32 * n + (col >> 4))) * 1024 + 16 * g + (col & 15)) = pack8(o0, o1); } }
    }
};
struct EpiGlu {
    static constexpr bool PERM = true, AFTER_DRAIN = false;
    const bf16_t* yg; bf16_t* ya; const float* bglu;
    __device__ __forceinline__ void operator()(const f32x4 (&acc)[2][2][4][2], const Unit& u, int wr, int wc, int fr, int fq) const {
        asm volatile("" : "+v"(fr), "+v"(fq));
        const int row0 = u.pm * BM + wr * 64 + fr, col0 = u.pn * BM + wc * 32 + 8 * fq;
#pragma unroll
        for (int ai = 0; ai < 2; ++ai)
#pragma unroll
            for (int m = 0; m < 4; ++m) { const int r = row0 + ai * HALF + m * 16;
#pragma unroll
                for (int bj = 0; bj < 2; ++bj) { const int c = col0 + bj * HALF; const f32x4 b0 = *(const f32x4*)(bglu + c), b1 = *(const f32x4*)(bglu + c + 4);
                    f32x4 y0, y1; unpack8(*(const u32x4*)(yg + (size_t)r * 1024 + c), y0, y1); f32x4 o0, o1;
#pragma unroll
                    for (int j = 0; j < 4; ++j) { o0[j] = y0[j] * sigm(acc[ai][bj][m][0][j] + b0[j]); o1[j] = y1[j] * sigm(acc[ai][bj][m][1][j] + b1[j]); }
                    *(u32x4*)(ya + (size_t)r * 1024 + c) = pack8(o0, o1); } }
    }
};
template <bool SECOND> struct EpiBranch {
    static constexpr bool PERM = true, AFTER_DRAIN = false;
    const bf16_t* gt; bf16_t* mg;
    __device__ __forceinline__ void operator()(const f32x4 (&acc)[2][2][4][2], const Unit& u, int wr, int wc, int fr, int fq) const {
        asm volatile("" : "+v"(fr), "+v"(fq));
        const int row0 = u.pm * BM + wr * 64 + fr, col0 = u.pn * BM + wc * 32 + 8 * fq;
#pragma unroll
        for (int ai = 0; ai < 2; ++ai)
#pragma unroll
            for (int m = 0; m < 4; ++m) { const int r = row0 + ai * HALF + m * 16;
#pragma unroll
                for (int bj = 0; bj < 2; ++bj) { const int c = col0 + bj * HALF; f32x4 g0, g1; unpack8(*(const u32x4*)(gt + (size_t)r * 4096 + c), g0, g1);
                    f32x4 o0 = g0 * acc[ai][bj][m][0], o1 = g1 * acc[ai][bj][m][1];
                    if (SECOND) { f32x4 p0, p1; unpack8(*(const u32x4*)(mg + (size_t)r * DM + c), p0, p1); o0 += p0; o1 += p1; }
                    *(u32x4*)(mg + (size_t)r * DM + c) = pack8(o0, o1); } }
    }
};
struct BatchOrder {
    int nunits, NJ, G, c; bool AL;
    __device__ __forceinline__ bool next(int i, Unit& u) const { const int L = i * G + c; if (L >= nunits) return false; u.pm = AL ? L : L / NJ; u.pn = L; return true; }
    __device__ __forceinline__ void a_ready(const Unit&) const {}
    __device__ __forceinline__ void done(const Unit&) const {}
};

template <class Epi, class Sched, bool ALIGN_EPI = false, bool SP2 = false>
__device__ __forceinline__ void gemm_phase(PG8_LAS unsigned char* lds, const Gemm g, const Sched& S, const Epi& E) {
    const int tid = threadIdx.x, wid = __builtin_amdgcn_readfirstlane(tid >> 6), lane = tid & 63, wr = wid >> 2, wc = wid & 3, fr = lane & 15, fq = lane >> 4;
    const int K = g.K, nt = K / BK;
    unsigned voffA[2], voffB[2];
#pragma unroll
    for (int i = 0; i < 2; ++i) { int R, C; stage_rc(tid * 16 + i * 8192, R, C); const int Rb = Epi::PERM ? ((R & ~31) + perm32(R & 31)) : R;
        voffA[i] = (unsigned)(R * K + C) * 2u; voffB[i] = (unsigned)(Rb * K + C) * 2u; }
    const size_t kstep = (size_t)(BK * 2);
    const size_t hstep = (size_t)HALF * K * 2;
    const size_t tstep = 2 * hstep;
    const unsigned ldsw = (unsigned)wid * 1024u;
    const int aoff = lds_byte(wr * 64 + fr, fq * 8), boff = lds_byte(wc * 32 + fr, fq * 8);
#define PG8_SA(b, h) (((b) * 2 + (h)) * HTB)
#define PG8_SB(b, h) ((4 + (b) * 2 + (h)) * HTB)
#define PG8_STAGE(bufoff, gbase, voff) do { _Pragma("unroll") for (int _i = 0; _i < 2; ++_i) \
        __builtin_amdgcn_global_load_lds((const unsigned*)((const char*)(gbase) + (voff)[_i]), (PG8_LAS unsigned*)(lds + (bufoff) + ldsw + _i * 8192), 16, 0, 0); } while (0)
#define PG8_LDA(dst, b, h) do { _Pragma("unroll") for (int m = 0; m < 4; ++m) _Pragma("unroll") for (int k = 0; k < 2; ++k) dst[m][k] = *(const PG8_LAS bf16x8*)(lds + PG8_SA(b, h) + aoff + m * 2048 + k * 1024); } while (0)
#define PG8_LDB(dst, b, h) do { _Pragma("unroll") for (int n = 0; n < 2; ++n) _Pragma("unroll") for (int k = 0; k < 2; ++k) dst[n][k] = *(const PG8_LAS bf16x8*)(lds + PG8_SB(b, h) + boff + n * 2048 + k * 1024); } while (0)
#define PG8_MMA(ai, bj, At, Bt) do { __builtin_amdgcn_s_setprio(1); _Pragma("unroll") for (int m = 0; m < 4; ++m) _Pragma("unroll") for (int n = 0; n < 2; ++n) _Pragma("unroll") for (int k = 0; k < 2; ++k) \
        acc[ai][bj][m][n] = __builtin_amdgcn_mfma_f32_16x16x32_bf16(Bt[n][k], At[m][k], acc[ai][bj][m][n], 0, 0, 0); __builtin_amdgcn_s_setprio(0); } while (0)
#define PG8_WAIT_V(n) asm volatile("s_waitcnt vmcnt(" #n ")" ::: "memory")
#define PG8_WAIT_L(n) asm volatile("s_waitcnt lgkmcnt(" #n ")" ::: "memory")
#define PG8_BAR __builtin_amdgcn_s_barrier()
#define PG8_SCHED __builtin_amdgcn_sched_barrier(0)
    Unit cur, nxt; int ui = 0;
    if (!S.next(0, cur)) return;
    f32x4 acc[2][2][4][2];
#pragma unroll
    for (int a = 0; a < 2; ++a)
#pragma unroll
        for (int b = 0; b < 2; ++b)
#pragma unroll
            for (int m = 0; m < 4; ++m)
#pragma unroll
                for (int n = 0; n < 2; ++n) acc[a][b][m][n] = (f32x4){0.f, 0.f, 0.f, 0.f};
    bf16x8 At[4][2], B0[2][2], B1[2][2];
    const char* cA = (const char*)g.A + (size_t)cur.pm * tstep; const char* cB = (const char*)g.Bt + (size_t)cur.pn * tstep;
    S.a_ready(cur);
    if constexpr (SP2) {
        PG8_STAGE(PG8_SB(0, 0), cB, voffB); PG8_STAGE(PG8_SB(0, 1), cB + hstep, voffB); PG8_STAGE(PG8_SA(0, 0), cA, voffA); PG8_STAGE(PG8_SA(0, 1), cA + hstep, voffA);
        if (wr == 1) PG8_BAR;
        PG8_WAIT_V(2); PG8_BAR;
        PG8_STAGE(PG8_SB(1, 0), cB + kstep, voffB); PG8_STAGE(PG8_SA(1, 0), cA + kstep, voffA); PG8_STAGE(PG8_SB(1, 1), cB + hstep + kstep, voffB);
        PG8_WAIT_V(6); PG8_BAR;
    } else {
        PG8_STAGE(PG8_SB(0, 0), cB, voffB); PG8_STAGE(PG8_SA(0, 0), cA, voffA); PG8_STAGE(PG8_SB(0, 1), cB + hstep, voffB); PG8_STAGE(PG8_SA(0, 1), cA + hstep, voffA);
        if (wr == 1) PG8_BAR;
        PG8_WAIT_V(4); PG8_BAR;
        PG8_STAGE(PG8_SB(1, 0), cB + kstep, voffB); PG8_STAGE(PG8_SA(1, 0), cA + kstep, voffA); PG8_STAGE(PG8_SB(1, 1), cB + hstep + kstep, voffB);
        PG8_WAIT_V(6); PG8_BAR;
    }
    for (;;) {
        const bool has_next = S.next(ui + 1, nxt);
        const char* nA = has_next ? (const char*)g.A + (size_t)nxt.pm * tstep : cA; const char* nB = has_next ? (const char*)g.Bt + (size_t)nxt.pn * tstep : cB;
#pragma nounroll
        for (int t = 0; t < nt; t += 2) {
            const bool last = (t == nt - 2);
            const char* a1 = cA + (size_t)(t + 1) * kstep;
            const char* a2 = last ? nA : cA + (size_t)(t + 2) * kstep; const char* b2 = last ? nB : cB + (size_t)(t + 2) * kstep;
            const char* a3 = a2 + kstep; const char* b3 = b2 + kstep;
            if (last && has_next) S.a_ready(nxt);
            if constexpr (SP2) {
            PG8_LDB(B0, 0, 0); PG8_LDB(B1, 0, 1); PG8_SCHED; PG8_LDA(At, 0, 0); PG8_STAGE(PG8_SA(1, 1), a1 + hstep, voffA);
            PG8_WAIT_V(8); PG8_WAIT_L(0); PG8_BAR; PG8_MMA(0, 0, At, B0); PG8_MMA(0, 1, At, B1); PG8_BAR; PG8_SCHED;
            PG8_LDA(At, 0, 1); PG8_STAGE(PG8_SB(0, 0), b2, voffB); PG8_STAGE(PG8_SB(0, 1), b2 + hstep, voffB); PG8_STAGE(PG8_SA(0, 0), a2, voffA);
            PG8_WAIT_V(8); PG8_WAIT_L(0); PG8_BAR; PG8_MMA(1, 0, At, B0); PG8_MMA(1, 1, At, B1); PG8_BAR; PG8_SCHED;
            PG8_LDB(B0, 1, 0); PG8_LDB(B1, 1, 1); PG8_SCHED; PG8_LDA(At, 1, 0); PG8_STAGE(PG8_SA(0, 1), a2 + hstep, voffA);
            PG8_WAIT_V(8); PG8_WAIT_L(0); PG8_BAR; PG8_MMA(0, 0, At, B0); PG8_MMA(0, 1, At, B1); PG8_BAR; PG8_SCHED;
            PG8_LDA(At, 1, 1); PG8_STAGE(PG8_SB(1, 0), b3, voffB); PG8_STAGE(PG8_SB(1, 1), b3 + hstep, voffB); PG8_STAGE(PG8_SA(1, 0), a3, voffA);
            PG8_WAIT_V(8); PG8_WAIT_L(0); PG8_BAR; PG8_MMA(1, 0, At, B0); PG8_MMA(1, 1, At, B1); PG8_BAR; PG8_SCHED;
            } else {
            PG8_LDB(B0, 0, 0); PG8_SCHED; PG8_LDA(At, 0, 0); PG8_STAGE(PG8_SA(1, 1), a1 + hstep, voffA);
            PG8_WAIT_L(8); PG8_BAR; PG8_WAIT_L(0); PG8_MMA(0, 0, At, B0); PG8_BAR; PG8_SCHED;
            PG8_LDB(B1, 0, 1); PG8_STAGE(PG8_SB(0, 0), b2, voffB);
            PG8_BAR; PG8_WAIT_L(0); PG8_MMA(0, 1, At, B1); PG8_BAR;
            PG8_LDA(At, 0, 1); PG8_STAGE(PG8_SA(0, 0), a2, voffA);
            PG8_BAR; PG8_WAIT_L(0); PG8_MMA(1, 0, At, B0); PG8_BAR; PG8_SCHED;
            PG8_STAGE(PG8_SB(0, 1), b2 + hstep, voffB);
            PG8_WAIT_V(6); PG8_BAR; PG8_MMA(1, 1, At, B1); PG8_BAR;
            PG8_LDB(B0, 1, 0); PG8_SCHED; PG8_LDA(At, 1, 0); PG8_STAGE(PG8_SA(0, 1), a2 + hstep, voffA);
            PG8_WAIT_L(8); PG8_BAR; PG8_WAIT_L(0); PG8_MMA(0, 0, At, B0); PG8_BAR; PG8_SCHED;
            PG8_LDB(B1, 1, 1); PG8_STAGE(PG8_SB(1, 0), b3, voffB);
            PG8_BAR; PG8_WAIT_L(0); PG8_MMA(0, 1, At, B1); PG8_BAR;
            PG8_LDA(At, 1, 1); PG8_STAGE(PG8_SA(1, 0), a3, voffA);
            PG8_BAR; PG8_WAIT_L(0); PG8_MMA(1, 0, At, B0); PG8_BAR; PG8_SCHED;
            PG8_STAGE(PG8_SB(1, 1), b3 + hstep, voffB);
            PG8_WAIT_V(6); PG8_BAR; PG8_MMA(1, 1, At, B1); PG8_BAR;
            }
        }
        if constexpr (ALIGN_EPI) { if (wr == 0) PG8_BAR; }
        if constexpr (!Epi::AFTER_DRAIN) { E(acc, cur, wr, wc, fr, fq); S.done(cur); }
        if (!has_next) break;
#pragma unroll
        for (int a = 0; a < 2; ++a)
#pragma unroll
            for (int b = 0; b < 2; ++b)
#pragma unroll
                for (int m = 0; m < 4; ++m)
#pragma unroll
                    for (int n = 0; n < 2; ++n) acc[a][b][m][n] = (f32x4){0.f, 0.f, 0.f, 0.f};
        cur = nxt; cA = nA; cB = nB; ++ui;
        if constexpr (ALIGN_EPI) { if (wr == 1) PG8_BAR; }
    }
    PG8_WAIT_V(0);
    if constexpr (!ALIGN_EPI) { if (wr == 0) PG8_BAR; }
    PG8_BAR;
    if constexpr (Epi::AFTER_DRAIN) { E.fused(acc, cur, wr, wc, fr, fq, lds, wid, lane); S.done(cur); }
#undef PG8_SA
#undef PG8_SB
#undef PG8_STAGE
#undef PG8_LDA
#undef PG8_LDB
#undef PG8_MMA
#undef PG8_WAIT_V
#undef PG8_WAIT_L
#undef PG8_BAR
#undef PG8_SCHED
}
}

constexpr int NWAVES = 8;
constexpr int N_LAUNCHES = MK_N_LAUNCHES;
constexpr int PER_PHASE = 12;
constexpr int M = 8192, D = 2048, FF = 5632, NMIX = 7168, SW = 1024;
constexpr int S5G = 64, S5P = 64, S5C = 16, LC = 32, NCH = M / LC;
constexpr size_t MiB = 1u << 20;
constexpr size_t WS_CTL = 0, CTL_ZERO_BYTES = 65536;
constexpr size_t WS_SMALL = 1 * MiB;
constexpr size_t SM_RSTD0 = 0, SM_A32 = 65536, SM_A1024 = 131072, SM_WSB = 262144;
constexpr size_t WS_SS = 2 * MiB, WS_LNST = 3 * MiB;
constexpr size_t WS_W1A = 4 * MiB, WS_W2A = 48 * MiB, WS_WMIX = 70 * MiB, WS_WGLU = 98 * MiB, WS_WA = 100 * MiB, WS_WB = 104 * MiB, WS_WOUT = 108 * MiB;
constexpr size_t WS_XB = 116 * MiB, WS_YLOC = WS_XB;
constexpr size_t WS_ACT = 148 * MiB;
constexpr size_t WS_GT = WS_ACT, WS_UB = 212 * MiB, WS_EST = 228 * MiB;
constexpr size_t WS_UA = 236 * MiB, WS_YA = WS_UA, WS_VB = 252 * MiB, WS_YB = 268 * MiB, WS_YG = 284 * MiB, WS_XIN = 300 * MiB, WS_GM = 316 * MiB;
constexpr size_t WS_W1B = 236 * MiB, WS_W2B = 280 * MiB;
constexpr size_t WS_TM = 332 * MiB, WS_MG = WS_TM, WS_END = 380 * MiB;
static_assert(WS_W1A + (size_t)2 * FF * D * 2 <= WS_W2A && WS_W2A + (size_t)D * FF * 2 <= WS_WMIX && WS_WMIX + (size_t)NMIX * D * 2 <= WS_WGLU, "ws map 1");
static_assert(WS_XB + (size_t)M * D * 2 <= WS_ACT && WS_YLOC + (size_t)S5G * NCH * 512 * 4 <= WS_ACT && WS_ACT + (size_t)M * FF * 2 <= WS_UA, "ws map 2");
static_assert(WS_GT + (size_t)M * 4096 * 2 <= WS_UB && WS_EST + (size_t)S5G * NCH * 128 * 4 <= WS_UA && WS_XIN + (size_t)128 * 256 * 256 * 2 <= WS_GM && WS_GM + (size_t)S5G * 512 * 256 * 2 <= WS_TM, "ws map 3");
static_assert(WS_W1B + (size_t)2 * FF * D * 2 <= WS_W2B && WS_W2B + (size_t)D * FF * 2 <= WS_GM && WS_TM + (size_t)S5G * 768 * 512 * 2 <= WS_END && WS_MG + (size_t)M * D * 2 <= WS_END, "ws map 4");
constexpr int CW_BAR = 4096;
constexpr int RING_OFF = 0, RING_BYTES = 131072, LDSCTL_OFF = RING_BYTES, MISC_OFF = LDSCTL_OFF + 320, LDS_BYTES = 147456;

#define GAS __attribute__((address_space(1)))
#define LAS __attribute__((address_space(3)))
typedef unsigned short bf16;
typedef unsigned v4u __attribute__((ext_vector_type(4)));
typedef float f32x4 __attribute__((ext_vector_type(4)));
typedef float f32x2 __attribute__((ext_vector_type(2)));
typedef short bf16x8 __attribute__((ext_vector_type(8)));
typedef GAS unsigned gu32;
#define RLX_AGENT __ATOMIC_RELAXED, __HIP_MEMORY_SCOPE_AGENT
using pg8::NORM_EPS;
#define LDS_WAIT() asm volatile("s_waitcnt lgkmcnt(0)" ::: "memory")
#define VM_WAIT() asm volatile("s_waitcnt vmcnt(0)" ::: "memory")
__device__ __forceinline__ unsigned f2bf(float f) { unsigned u = __builtin_bit_cast(unsigned, f); return (u + 0x7fffu + ((u >> 16) & 1u)) >> 16; }
__device__ __forceinline__ unsigned pk2(float lo, float hi) { return f2bf(lo) | (f2bf(hi) << 16); }

#define XB_TMO      128
#define XB_XCNT(j)  (256  + 64 * (j))
#define XB_XSUB(j)  (1280 + 64 * (j))
#define XB_XGEN(j)  (2304 + 64 * (j))
#define XB_TOP      3328
#define XB_TOPGEN   3392
#define XCD_BAR_WORDS 3456
#define XB_SPIN_CAP (1u << 18)

__device__ __forceinline__ unsigned xb_ld(unsigned* p)              { return __hip_atomic_load(p, __ATOMIC_RELAXED, __HIP_MEMORY_SCOPE_AGENT); }
__device__ __forceinline__ unsigned xb_add(unsigned* p, unsigned v) { return __hip_atomic_fetch_add(p, v, __ATOMIC_RELAXED, __HIP_MEMORY_SCOPE_AGENT); }
__device__ __forceinline__ unsigned xb_xcc_id() { return (unsigned)__builtin_amdgcn_s_getreg((3 << 11) | 20) & 0xFu; }
#define XB_SPIN(cond, bar) do { unsigned _sp = 0; while (cond) { __builtin_amdgcn_s_sleep(1); \
    if ((++_sp & 255u) == 0u) { if (xb_ld(&(bar)[XB_TMO])) break; if (_sp > XB_SPIN_CAP) { atomicAdd(&(bar)[XB_TMO], 1u); break; } } } } while (0)

struct XcdBarrier {
    unsigned* bar; unsigned x;
    volatile LAS unsigned* st;
};

__device__ __forceinline__ XcdBarrier xcd_barrier_post(unsigned* bar, volatile LAS unsigned* st) {
    XcdBarrier b; b.bar = bar; b.x = xb_xcc_id(); b.st = st;
    if (threadIdx.x == 0) (void)xb_add(&bar[XB_XCNT(b.x)], 1u);
    return b;
}
__device__ __forceinline__ void xcd_barrier_complete(unsigned* bar, unsigned x, unsigned& nloc, unsigned& nx) {
    const unsigned G = gridDim.x * gridDim.y * gridDim.z;
    unsigned sum, cnt, mine, sp = 0u;
    for (;;) {
        sum = 0u; cnt = 0u; mine = 0u;
#pragma unroll
        for (unsigned j = 0; j < 16; ++j) { const unsigned c = xb_ld(&bar[XB_XCNT(j)]); sum += c; cnt += (c > 0u) ? 1u : 0u; mine = (j == x) ? c : mine; }
        if (sum == G) break;
        __builtin_amdgcn_s_sleep(1);
        if ((++sp & 255u) == 0u) { if (xb_ld(&bar[XB_TMO])) break; if (sp > XB_SPIN_CAP) { atomicAdd(&bar[XB_TMO], 1u); break; } }
    }
    nloc = mine > 0u ? mine : 1u; nx = cnt > 0u ? cnt : 1u;
}

__device__ __forceinline__ void xcd_barrier(const XcdBarrier& b) {
    asm volatile("s_waitcnt vmcnt(0)" ::: "memory");
    __syncthreads();
    if (threadIdx.x == 0) {
        unsigned* bar = b.bar;
        __builtin_amdgcn_s_waitcnt(0);
        unsigned nloc = b.st[0], nx = b.st[1];
        if (nloc == 0u) { xcd_barrier_complete(bar, b.x, nloc, nx); b.st[0] = nloc; b.st[1] = nx; }
        const unsigned old = xb_add(&bar[XB_XSUB(b.x)], 1u);
        const unsigned gen = old / nloc;
        if (old + 1u == (gen + 1u) * nloc) {
            __builtin_amdgcn_fence(__ATOMIC_RELEASE, "agent");
            asm volatile("s_waitcnt vmcnt(0)" ::: "memory");
            const unsigned og = xb_add(&bar[XB_TOP], 1u);
            const unsigned tg = og / nx;
            if (og + 1u == (tg + 1u) * nx) xb_add(&bar[XB_TOPGEN], 1u);
            else XB_SPIN(xb_ld(&bar[XB_TOPGEN]) == tg, bar);
            __builtin_amdgcn_fence(__ATOMIC_ACQUIRE, "agent");
            xb_add(&bar[XB_XGEN(b.x)], 1u);
            asm volatile("s_waitcnt vmcnt(0)" ::: "memory");
        } else {
            XB_SPIN(xb_ld(&bar[XB_XGEN(b.x)]) == gen, bar);
            __builtin_amdgcn_fence(__ATOMIC_ACQUIRE, "agent");
            asm volatile("s_waitcnt vmcnt(0)" ::: "memory");
        }
    }
    __syncthreads();
}

__device__ __forceinline__ float wave_sum(float v) {
#pragma unroll
    for (int o = 1; o < 64; o <<= 1) v += __shfl_xor(v, o);
    return v;
}
struct CvtDesc { const float* W; const float* gain; bf16* WT; int K, N, row_off, mode; };
__device__ __forceinline__ void cvt_item(const CvtDesc& d, LAS unsigned char* scr, int item, int lane) {
    const int nblk = d.N / 64, kb = item / nblk, nb = item - kb * nblk, k0 = 64 * kb, n0 = 64 * nb;
    const int drow0 = d.mode == 0 ? d.row_off + n0 : ((n0 >> 7) * 256 + (n0 & 127) + (d.mode == 2 ? 128 : 0));
    const GAS float* src = (const GAS float*)d.W + (size_t)k0 * d.N + n0 + lane;
    float v[64];
#pragma unroll
    for (int i = 0; i < 64; ++i) v[i] = src[(size_t)i * d.N];
    if (d.gain) {
#pragma unroll
        for (int i = 0; i < 64; ++i) v[i] *= d.gain[k0 + i];
    }
#pragma unroll
    for (int c = 0; c < 8; ++c) { v4u o; o.x = pk2(v[8 * c], v[8 * c + 1]); o.y = pk2(v[8 * c + 2], v[8 * c + 3]); o.z = pk2(v[8 * c + 4], v[8 * c + 5]); o.w = pk2(v[8 * c + 6], v[8 * c + 7]);
        *(LAS v4u*)(scr + lane * 144 + c * 16) = o; }
    LDS_WAIT(); asm volatile("" ::: "memory");
    const int ch = lane & 7, r8 = lane >> 3;
#pragma unroll
    for (int i = 0; i < 8; ++i) { const int n = r8 + 8 * i; const v4u o = *(const LAS v4u*)(scr + n * 144 + ch * 16);
        *(GAS v4u*)(d.WT + (size_t)(drow0 + n) * d.K + k0 + 8 * ch) = o; }
    LDS_WAIT(); asm volatile("" ::: "memory");
}
template <int ND> __device__ __forceinline__ void cvt_run(const CvtDesc (&ds)[ND], LAS unsigned char* lds, int gw, int NGW, int wave, int lane) {
    LAS unsigned char* scr = lds + RING_OFF + wave * 16384;
    int total = 0;
#pragma unroll
    for (int i = 0; i < ND; ++i) total += (ds[i].K / 64) * (ds[i].N / 64);
    for (int it = gw; it < total; it += NGW) { int r = __builtin_amdgcn_readfirstlane(it);
#pragma unroll
        for (int i = 0; i < ND; ++i) { const int ni = (ds[i].K / 64) * (ds[i].N / 64); if (r >= 0 && r < ni) cvt_item(ds[i], scr, r, lane); r -= ni; } }
}
__device__ __forceinline__ void x_row_to_bf16(const float* xrow, bf16* orow, float* rstd_out, int lane) {
    const GAS f32x4* xr = (const GAS f32x4*)xrow + lane; f32x4 v[8]; float s = 0.f;
#pragma unroll
    for (int j = 0; j < 8; ++j) { v[j] = xr[64 * j]; s += (v[j][0] * v[j][0] + v[j][1] * v[j][1]) + (v[j][2] * v[j][2] + v[j][3] * v[j][3]); }
    s = wave_sum(s);
    GAS unsigned long long* o8 = (GAS unsigned long long*)orow + lane;
#pragma unroll
    for (int j = 0; j < 8; ++j) o8[64 * j] = (unsigned long long)pk2(v[j][0], v[j][1]) | ((unsigned long long)pk2(v[j][2], v[j][3]) << 32);
    if (lane == 0) *rstd_out = rsqrtf(s * (1.0f / D) + NORM_EPS);
}
__device__ __forceinline__ void sincos_d(double x, double& sn, double& cs) {
    const double n = __builtin_rint(x * 0.63661977236758134308);
    double r = __builtin_fma(-n, 1.57079632679489655800e+00, x); r = __builtin_fma(-n, 6.12323399573676603587e-17, r);
    const double z = r * r;
    const double s = r * (1.0 + z * (-1.0 / 6 + z * (1.0 / 120 + z * (-1.0 / 5040 + z * (1.0 / 362880 + z * (-1.0 / 39916800 + z * (1.0 / 6227020800.0)))))));
    const double c = 1.0 + z * (-0.5 + z * (1.0 / 24 + z * (-1.0 / 720 + z * (1.0 / 40320 + z * (-1.0 / 3628800 + z * (1.0 / 479001600 + z * (-1.0 / 87178291200.0)))))));
    const int q = (int)((long long)n & 3);
    sn = (q == 0) ? s : (q == 1) ? c : (q == 2) ? -s : -c;
    cs = (q == 0) ? c : (q == 1) ? -s : (q == 2) ? -c : s;
}
__device__ __forceinline__ void s5_pow(double lr, double li, double dt, double tau, double& pr, double& pi) {
    const double mag = exp(lr * dt * tau); double sn, cs; sincos_d(li * dt * tau, sn, cs); pr = mag * cs; pi = mag * sn;
}
struct S5In { const float *a_re, *a_im, *log_dt, *b_re, *b_im, *c_re, *c_im, *dsk; };
__device__ __forceinline__ void s5_tables_item(const S5In& in, LAS unsigned char* lds, unsigned char* ws, int g, int q, int tid) {
    LAS f32x2* pw = (LAS f32x2*)(lds + RING_OFF);
    LAS f32x2* bk = (LAS f32x2*)(lds + RING_OFF + 17408);
    LAS f32x2* cg = (LAS f32x2*)(lds + RING_OFF + 25600);
    LAS float* kt = (LAS float*)(lds + RING_OFF + 33792);
    const double dt = exp((double)in.log_dt[g]);
    for (int e = tid; e < 33 * 64; e += NWAVES * 64) { const int tau = e >> 6, p = e & 63; double pr, pi; s5_pow((double)in.a_re[g * 64 + p], (double)in.a_im[g * 64 + p], dt, (double)tau, pr, pi);
        pw[e] = (f32x2){(float)pr, (float)pi};
        if (tau == 32 && q == 0) ((f32x2*)(ws + WS_SMALL + SM_A32))[g * 64 + p] = (f32x2){(float)pr, (float)pi}; }
    if (q == 0 && tid < 64) { const int p = tid; double pr, pi; s5_pow((double)in.a_re[g * 64 + p], (double)in.a_im[g * 64 + p], dt, 1024.0, pr, pi); ((f32x2*)(ws + WS_SMALL + SM_A1024))[g * 64 + p] = (f32x2){(float)pr, (float)pi}; }
    for (int e = tid; e < 1024; e += NWAVES * 64) { const int p = e >> 4, c = e & 15; const double lr = (double)in.a_re[g * 64 + p], li = (double)in.a_im[g * 64 + p]; double ar, ai; s5_pow(lr, li, dt, 1.0, ar, ai);
        const double nr = ar - 1.0, ni = ai, den = lr * lr + li * li, kr = (nr * lr + ni * li) / den, ki = (ni * lr - nr * li) / den;
        const double br = (double)in.b_re[((size_t)g * 64 + p) * 16 + c], bi = (double)in.b_im[((size_t)g * 64 + p) * 16 + c];
        bk[e] = (f32x2){(float)(kr * br - ki * bi), (float)(kr * bi + ki * br)};
        const int c2 = e >> 6, p2 = e & 63; cg[e] = (f32x2){in.c_re[((size_t)g * 16 + c2) * 64 + p2], in.c_im[((size_t)g * 16 + c2) * 64 + p2]}; }
    LDS_WAIT(); __syncthreads();
    for (int e = tid; e < 32 * 256; e += NWAVES * 64) { const int tau = e >> 8, c2 = (e >> 4) & 15, c = e & 15; float s = 0.f;
        for (int p = 0; p < 64; ++p) { const f32x2 a = pw[tau * 64 + p], b = bk[p * 16 + c], cc = cg[c2 * 64 + p]; const float wr_ = a[0] * b[0] - a[1] * b[1], wi_ = a[0] * b[1] + a[1] * b[0]; s += cc[0] * wr_ - cc[1] * wi_; }
        if (tau == 0 && c2 == c) s += in.dsk[g * 16 + c];
        kt[e] = s; }
    LDS_WAIT(); __syncthreads();
    bf16* tm = (bf16*)(ws + WS_TM) + (size_t)g * 768 * 512;
    for (int e = tid; e < 192 * 64; e += NWAVES * 64) { const int rho = 192 * q + (e >> 6), kc = (e & 63) * 8, s = kc >> 4, c0 = kc & 15; float v[8];
#pragma unroll
        for (int j = 0; j < 8; ++j) { const int c = c0 + j; float x = 0.f;
            if (rho < 512) { const int t = rho >> 4, c2 = rho & 15; if (s <= t) x = kt[((t - s) * 16 + c2) * 16 + c]; }
            else if (rho < 640) { const int p = (rho - 512) & 63; const f32x2 a = pw[(31 - s) * 64 + p], b = bk[p * 16 + c]; x = rho < 576 ? (a[0] * b[0] - a[1] * b[1]) : (a[0] * b[1] + a[1] * b[0]); }
            v[j] = x; }
        v4u o; o.x = pk2(v[0], v[1]); o.y = pk2(v[2], v[3]); o.z = pk2(v[4], v[5]); o.w = pk2(v[6], v[7]);
        *(GAS v4u*)(tm + (size_t)rho * 512 + kc) = o; }
    bf16* gm = (bf16*)(ws + WS_GM) + (size_t)g * 512 * 256;
    for (int e = tid; e < 128 * 32; e += NWAVES * 64) { const int rho = 128 * q + (e >> 5), kc = (e & 31) * 8, t = rho >> 4, c2 = rho & 15; float v[8];
#pragma unroll
        for (int j = 0; j < 8; ++j) { const int k = kc + j; float x = 0.f;
            if (k < 128) { const int p = k & 63; const f32x2 a = pw[(t + 1) * 64 + p], cc = cg[c2 * 64 + p]; x = k < 64 ? (cc[0] * a[0] - cc[1] * a[1]) : -(cc[0] * a[1] + cc[1] * a[0]); }
            v[j] = x; }
        v4u o; o.x = pk2(v[0], v[1]); o.y = pk2(v[2], v[3]); o.z = pk2(v[4], v[5]); o.w = pk2(v[6], v[7]);
        *(GAS v4u*)(gm + (size_t)rho * 256 + kc) = o; }
    LDS_WAIT(); __syncthreads();
}
__device__ __forceinline__ void s5_scan(LAS unsigned char* lds, const unsigned char* ws, bf16* xin, int g, int wave, int lane) {
    const f32x2 a32 = ((const f32x2*)(ws + WS_SMALL + SM_A32))[g * 64 + lane], a1k = ((const f32x2*)(ws + WS_SMALL + SM_A1024))[g * 64 + lane];
    const float* eg = (const float*)(ws + WS_EST) + ((size_t)g * 256 + 32 * wave) * 128;
    float er[32], ei[32];
#pragma unroll
    for (int i = 0; i < 32; ++i) { er[i] = eg[i * 128 + lane]; ei[i] = eg[i * 128 + 64 + lane]; }
    float sr = 0.f, si = 0.f;
#pragma unroll
    for (int i = 0; i < 32; ++i) { const float nr = a32[0] * sr - a32[1] * si + er[i], ni = a32[0] * si + a32[1] * sr + ei[i]; sr = nr; si = ni; }
    LAS f32x2* seg = (LAS f32x2*)(lds + RING_OFF);
    seg[wave * 64 + lane] = (f32x2){sr, si};
    LDS_WAIT(); __syncthreads();
    sr = 0.f; si = 0.f;
    for (int w = 0; w < wave; ++w) { const f32x2 e = seg[w * 64 + lane]; const float nr = a1k[0] * sr - a1k[1] * si + e[0], ni = a1k[0] * si + a1k[1] * sr + e[1]; sr = nr; si = ni; }
    bf16* xo = xin + (size_t)(32 * wave) * 256;
#pragma unroll
    for (int i = 0; i < 32; ++i) { xo[i * 256 + lane] = (bf16)f2bf(sr); xo[i * 256 + 64 + lane] = (bf16)f2bf(si); xo[i * 256 + 128 + lane] = 0; xo[i * 256 + 192 + lane] = 0;
        const float nr = a32[0] * sr - a32[1] * si + er[i], ni = a32[0] * si + a32[1] * sr + ei[i]; sr = nr; si = ni; }
    VM_WAIT(); LDS_WAIT(); __syncthreads();
}
__device__ __forceinline__ void sgu_item(LAS unsigned char* lds, const unsigned char* ws, const float* ln_g, const float* ln_b, const float* b_s, int n, int h, int tid, int wave, int lane) {
    constexpr int RS = 136;
    LAS bf16* vT = (LAS bf16*)(lds + RING_OFF);
    LAS float* mu = (LAS float*)(lds + RING_OFF + 128 * RS * 2);
    LAS float* rsd = mu + 128;
    const int t0 = 128 * n, c0 = 128 * h;
    if (tid < 128) { const f32x4* p = (const f32x4*)((const float*)(ws + WS_LNST) + (size_t)(t0 + tid) * 32); float s1 = 0.f, s2 = 0.f;
#pragma unroll
        for (int i = 0; i < 8; ++i) { const f32x4 a = p[i]; s1 += a[0] + a[2]; s2 += a[1] + a[3]; }
        const float m_ = s1 * (1.0f / 1024.0f), var = s2 * (1.0f / 1024.0f) - m_ * m_; mu[tid] = m_; rsd[tid] = rsqrtf(fmaxf(var, 0.f) + NORM_EPS); }
    LDS_WAIT(); __syncthreads();
    { const int cgp = tid & 15; f32x4 g0 = *(const f32x4*)(ln_g + c0 + 8 * cgp), g1 = *(const f32x4*)(ln_g + c0 + 8 * cgp + 4), b0 = *(const f32x4*)(ln_b + c0 + 8 * cgp), b1 = *(const f32x4*)(ln_b + c0 + 8 * cgp + 4);
#pragma unroll
        for (int i = 0; i < 4; ++i) { const int s = (tid >> 4) + 32 * i; const v4u w = *(const GAS v4u*)((const bf16*)(ws + WS_VB) + (size_t)(t0 + s) * 1024 + c0 + 8 * cgp);
            const float m_ = mu[s], r_ = rsd[s]; float x[8] = {pg8::bf_lo(w.x), pg8::bf_hi(w.x), pg8::bf_lo(w.y), pg8::bf_hi(w.y), pg8::bf_lo(w.z), pg8::bf_hi(w.z), pg8::bf_lo(w.w), pg8::bf_hi(w.w)};
#pragma unroll
            for (int j = 0; j < 8; ++j) { const float gg = j < 4 ? g0[j & 3] : g1[j & 3], bb = j < 4 ? b0[j & 3] : b1[j & 3]; vT[(8 * cgp + j) * RS + s] = (bf16)f2bf((x[j] - m_) * r_ * gg + bb); } } }
    LDS_WAIT(); __syncthreads();
    const bf16* wsb = (const bf16*)(ws + WS_SMALL + SM_WSB) + (size_t)h * 128 * 128;
    const int fr = lane & 15, fq = lane >> 4, t = 16 * wave + fr;
    bf16x8 bfr[4];
#pragma unroll
    for (int kk = 0; kk < 4; ++kk) bfr[kk] = *(const GAS bf16x8*)(wsb + (size_t)t * 128 + kk * 32 + 8 * fq);
    f32x4 acc[8];
#pragma unroll
    for (int ct = 0; ct < 8; ++ct) { acc[ct] = (f32x4){0.f, 0.f, 0.f, 0.f};
#pragma unroll
        for (int kk = 0; kk < 4; ++kk) { const bf16x8 af = *(const LAS bf16x8*)(vT + (16 * ct + fr) * RS + kk * 32 + 8 * fq); acc[ct] = __builtin_amdgcn_mfma_f32_16x16x32_bf16(af, bfr[kk], acc[ct], 0, 0, 0); } }
    const float bias = b_s[h * 128 + t]; const size_t orow = (size_t)(t0 + t) * 1024 + c0;
#pragma unroll
    for (int ct = 0; ct < 8; ++ct) { const int c = 16 * ct + 4 * fq; const pg8::u32x2 uw = *(const GAS pg8::u32x2*)((const bf16*)(ws + WS_UB) + orow + c);
        pg8::u32x2 o; o.x = pg8::cvt_pk_bf16(pg8::bf_lo(uw.x) * (acc[ct][0] + bias), pg8::bf_hi(uw.x) * (acc[ct][1] + bias)); o.y = pg8::cvt_pk_bf16(pg8::bf_lo(uw.y) * (acc[ct][2] + bias), pg8::bf_hi(uw.y) * (acc[ct][3] + bias));
        *(GAS pg8::u32x2*)((bf16*)(ws + WS_YB) + orow + c) = o; }
    LDS_WAIT(); __syncthreads();
}
__device__ __forceinline__ void final_row(float* xrow, const float* ssrow, const float* fn, int lane) {
    float s = lane < 32 ? ssrow[lane] : 0.f; s = wave_sum(s); const float rstd = rsqrtf(s * (1.0f / D) + NORM_EPS);
    GAS f32x4* xr = (GAS f32x4*)xrow + lane; const GAS f32x4* gr = (const GAS f32x4*)fn + lane;
#pragma unroll
    for (int j = 0; j < 8; ++j) { const f32x4 v = xr[64 * j] * rstd * gr[64 * j]; xr[64 * j] = v; }
}

struct Args { const float* in[31]; float* out; unsigned char* ws; int ph_lo, ph_hi; };
enum { I_X = 0, I_F1N, I_F1G, I_F1U, I_F1D, I_MIXN, I_WIN, I_ARE, I_AIM, I_LDT, I_BRE, I_BIM, I_CRE, I_CIM, I_DSK, I_WGLU, I_BGLU, I_LNG, I_LNB, I_WS, I_BS, I_WBA, I_WBB, I_WG, I_BG, I_WOUT, I_F2N, I_F2G, I_F2U, I_F2D, I_FN };
typedef const __attribute__((address_space(4))) Args* KArgsP;
__device__ __forceinline__ KArgsP kargs() { KArgsP p = (KArgsP)__builtin_amdgcn_kernarg_segment_ptr(); asm volatile("" : "+s"(p)); return p; }
#define AIN(i) (kargs()->in[i])
__global__ void __launch_bounds__(NWAVES * 64, 2) mk_fwd(Args args_unused) {
    extern __shared__ __attribute__((aligned(16))) unsigned char lds_raw[];
    LAS unsigned char* lds = (LAS unsigned char*)lds_raw;
    const int tid = threadIdx.x, lane = tid & 63, wave = __builtin_amdgcn_readfirstlane(tid >> 6);
    const int G = gridDim.x, bx = blockIdx.x;
    const int vcu = (G % 8 == 0) ? (bx % 8) * (G / 8) + bx / 8 : bx;
    unsigned char* const ws = kargs()->ws;
    for (int u = tid; u < (LDS_BYTES - LDSCTL_OFF) / 4; u += NWAVES * 64) ((LAS unsigned*)(lds + LDSCTL_OFF))[u] = 0u;
    __syncthreads();
    XcdBarrier bar; bar.bar = (unsigned*)(ws + WS_CTL) + CW_BAR; bar.x = 0; bar.st = nullptr;
    if (N_LAUNCHES == 1) bar = xcd_barrier_post((unsigned*)(ws + WS_CTL) + CW_BAR, (volatile LAS unsigned*)(lds + MISC_OFF) + 8);
    const int lo = kargs()->ph_lo, hi = kargs()->ph_hi;
#ifndef PH_MASK
#define PH_MASK 0xfff
#endif
#define IN(k) (((PH_MASK >> (k)) & 1) && lo <= (k) && (k) < hi)
#ifndef REP_MASK
#define REP_MASK 0
#endif
#define REPS(k) for (int rep_ = 0; rep_ < 1 + ((REP_MASK >> (k)) & 1); ++rep_)
#define SEAM(k) do { if (IN(k) && IN((k) + 1)) xcd_barrier(bar); } while (0)
    const int gw = vcu * NWAVES + wave, NGW = G * NWAVES;
    bf16* const XB = (bf16*)(ws + WS_XB); bf16* const ACT = (bf16*)(ws + WS_ACT); float* const SS = (float*)(ws + WS_SS);
    LAS unsigned char* ring = lds + RING_OFF;

    if (IN(0)) REPS(0) {
        const CvtDesc ds[8] = {
            {AIN(I_F1G), AIN(I_F1N), (bf16*)(ws + WS_W1A), D, FF, 0, 1}, {AIN(I_F1U), AIN(I_F1N), (bf16*)(ws + WS_W1A), D, FF, 0, 2},
            {AIN(I_F1D), nullptr, (bf16*)(ws + WS_W2A), FF, D, 0, 0},
            {AIN(I_WIN), AIN(I_MIXN), (bf16*)(ws + WS_WMIX), D, 3072, 0, 0}, {AIN(I_WG), AIN(I_MIXN), (bf16*)(ws + WS_WMIX), D, 4096, 3072, 0},
            {AIN(I_WGLU), nullptr, (bf16*)(ws + WS_WGLU), SW, SW, 0, 0},
            {AIN(I_WBA), nullptr, (bf16*)(ws + WS_WA), SW, D, 0, 0}, {AIN(I_WBB), nullptr, (bf16*)(ws + WS_WB), SW, D, 0, 0} };
        cvt_run<8>(ds, lds, gw, NGW, wave, lane);
        const CvtDesc d2[1] = { {AIN(I_WOUT), nullptr, (bf16*)(ws + WS_WOUT), D, D, 0, 0} };
        cvt_run<1>(d2, lds, gw, NGW, wave, lane);
        for (int m = gw; m < M; m += NGW) x_row_to_bf16(AIN(I_X) + (size_t)m * D, XB + (size_t)m * D, (float*)(ws + WS_SMALL + SM_RSTD0) + m, lane);
        { const float* w_s = AIN(I_WS); bf16* wsb = (bf16*)(ws + WS_SMALL + SM_WSB);
          for (int e = bx * (NWAVES * 64) + tid; e < 8 * 128 * 128; e += G * NWAVES * 64) { const int t = (e >> 7) & 127, s = e & 127; wsb[e] = (bf16)f2bf(((t >> 6) >= (s >> 6)) ? w_s[e] : 0.f); } }
        __syncthreads();
        const S5In s5{AIN(I_ARE), AIN(I_AIM), AIN(I_LDT), AIN(I_BRE), AIN(I_BIM), AIN(I_CRE), AIN(I_CIM), AIN(I_DSK)};
        for (int it = bx; it < 256; it += G) s5_tables_item(s5, lds, ws, it & 63, it >> 6, tid);
    }
    SEAM(0);
    if (IN(1)) REPS(1) {
        pg8::Gemm g{XB, (const bf16*)(ws + WS_W1A), M, 2 * FF, D}; pg8::StaticOrder S; S.init(M, 2 * FF, G, bx);
        pg8::EpiFfnUp<0> E{ACT, FF, (const float*)(ws + WS_SMALL + SM_RSTD0)};
        pg8::gemm_phase<pg8::EpiFfnUp<0>, pg8::StaticOrder, true, true>(ring, g, S, E);
    }
    SEAM(1);
    if (IN(2)) REPS(2) {
        pg8::Gemm g{ACT, (const bf16*)(ws + WS_W2A), M, D, FF}; pg8::StaticOrder S; S.init(M, D, G, bx);
        pg8::EpiResid<true> E{AIN(I_X), kargs()->out, XB, SS, 0.5f};
        pg8::gemm_phase<pg8::EpiResid<true>, pg8::StaticOrder, true, true>(ring, g, S, E);
    }
    SEAM(2);
    if (IN(3)) REPS(3) {
        pg8::Gemm g{XB, (const bf16*)(ws + WS_WMIX), M, NMIX, D}; pg8::StaticOrder S; S.init(M, NMIX, G, bx);
        pg8::EpiMixIn E{(bf16*)(ws + WS_UA), (bf16*)(ws + WS_UB), (bf16*)(ws + WS_VB), (bf16*)(ws + WS_GT), (float*)(ws + WS_LNST), SS, AIN(I_BG)};
        pg8::gemm_phase<pg8::EpiMixIn, pg8::StaticOrder, true, true>(ring, g, S, E);
    }
    SEAM(3);
    if (IN(4)) REPS(4) {
        pg8::Gemm g{(const bf16*)(ws + WS_UA), (const bf16*)(ws + WS_TM), S5G * 256, 768 * S5G, 512}; pg8::BatchOrder S{192, 3, G, bx, false};
        pg8::EpiS5Loc E{(float*)(ws + WS_YLOC), (float*)(ws + WS_EST)};
        pg8::gemm_phase<pg8::EpiS5Loc, pg8::BatchOrder, true, true>(ring, g, S, E);
        __syncthreads();
        if (G == 256) {
            if (bx >= 192) for (int i = 0; i < 4; ++i) { const int it = (bx - 192) * 4 + i; sgu_item(lds, ws, AIN(I_LNG), AIN(I_LNB), AIN(I_BS), it >> 3, it & 7, tid, wave, lane); }
            { const int it = 256 + bx; sgu_item(lds, ws, AIN(I_LNG), AIN(I_LNB), AIN(I_BS), it >> 3, it & 7, tid, wave, lane); }
        } else { for (int it = bx; it < 512; it += G) sgu_item(lds, ws, AIN(I_LNG), AIN(I_LNB), AIN(I_BS), it >> 3, it & 7, tid, wave, lane); }
    }
    SEAM(4);
    if (IN(5)) REPS(5) {
        for (int L = bx; L < 128; L += G) s5_scan(lds, ws, (bf16*)(ws + WS_XIN) + (size_t)L * 256 * 256, L >> 1, wave, lane);
        pg8::Gemm g{(const bf16*)(ws + WS_XIN), (const bf16*)(ws + WS_GM), 128 * 256, 512 * S5G, 256}; pg8::BatchOrder S{128, 2, G, bx, true};
        pg8::EpiS5Out E{(const float*)(ws + WS_YLOC), (bf16*)(ws + WS_YG)};
        pg8::gemm_phase<pg8::EpiS5Out, pg8::BatchOrder, true, true>(ring, g, S, E);
    }
    SEAM(5);
    if (IN(6)) REPS(6) {
        pg8::Gemm g{(const bf16*)(ws + WS_YG), (const bf16*)(ws + WS_WGLU), M, SW, SW}; pg8::StaticOrder S; S.init(M, SW, G, bx);
        pg8::EpiGlu E{(const bf16*)(ws + WS_YG), (bf16*)(ws + WS_YA), AIN(I_BGLU)};
        pg8::gemm_phase<pg8::EpiGlu, pg8::StaticOrder, true, true>(ring, g, S, E);
    }
    SEAM(6);
    if (IN(7)) REPS(7) {
        { pg8::Gemm g{(const bf16*)(ws + WS_YA), (const bf16*)(ws + WS_WA), M, D, SW}; pg8::StaticOrder S; S.init(M, D, G, bx);
          pg8::EpiBranch<false> E{(const bf16*)(ws + WS_GT), (bf16*)(ws + WS_MG)};
          pg8::gemm_phase<pg8::EpiBranch<false>, pg8::StaticOrder, true, true>(ring, g, S, E); }
        __syncthreads();
        { pg8::Gemm g{(const bf16*)(ws + WS_YB), (const bf16*)(ws + WS_WB), M, D, SW}; pg8::StaticOrder S; S.init(M, D, G, bx);
          pg8::EpiBranch<true> E{(const bf16*)(ws + WS_GT) + 2048, (bf16*)(ws + WS_MG)};
          pg8::gemm_phase<pg8::EpiBranch<true>, pg8::StaticOrder, true, true>(ring, g, S, E); }
    }
    SEAM(7);
    if (IN(8)) REPS(8) {
        const CvtDesc ds[3] = { {AIN(I_F2G), AIN(I_F2N), (bf16*)(ws + WS_W1B), D, FF, 0, 1}, {AIN(I_F2U), AIN(I_F2N), (bf16*)(ws + WS_W1B), D, FF, 0, 2}, {AIN(I_F2D), nullptr, (bf16*)(ws + WS_W2B), FF, D, 0, 0} };
        cvt_run<3>(ds, lds, gw, NGW, wave, lane);
        __syncthreads();
        pg8::Gemm g{(const bf16*)(ws + WS_MG), (const bf16*)(ws + WS_WOUT), M, D, D}; pg8::StaticOrder S; S.init(M, D, G, bx);
        pg8::EpiResid<true> E{kargs()->out, kargs()->out, XB, SS, 1.0f};
        pg8::gemm_phase<pg8::EpiResid<true>, pg8::StaticOrder, true, true>(ring, g, S, E);
    }
    SEAM(8);
    if (IN(9)) REPS(9) {
        pg8::Gemm g{XB, (const bf16*)(ws + WS_W1B), M, 2 * FF, D}; pg8::StaticOrder S; S.init(M, 2 * FF, G, bx);
        pg8::EpiFfnUp<1> E{ACT, FF, SS};
        pg8::gemm_phase<pg8::EpiFfnUp<1>, pg8::StaticOrder, true, true>(ring, g, S, E);
    }
    SEAM(9);
    if (IN(10)) REPS(10) {
        pg8::Gemm g{ACT, (const bf16*)(ws + WS_W2B), M, D, FF}; pg8::StaticOrder S; S.init(M, D, G, bx);
        pg8::EpiResid<false> E{kargs()->out, kargs()->out, nullptr, SS, 0.5f};
        pg8::gemm_phase<pg8::EpiResid<false>, pg8::StaticOrder, true, true>(ring, g, S, E);
    }
    SEAM(10);
    if (IN(11)) REPS(11) { for (int m = gw; m < M; m += NGW) final_row(kargs()->out + (size_t)m * D, SS + (size_t)m * 32, AIN(I_FN), lane); }
#undef IN
#undef SEAM
}

extern "C" void kernel_launch(void* const* d_in, const int* in_sizes, int n_in, void* d_out, int out_size, void* d_ws, size_t ws_size, hipStream_t stream) {
    static int grid = 0;
    if (grid == 0) {
        if (n_in != 31 || in_sizes[0] != M * D || out_size != M * D || ws_size < WS_END) { fprintf(stderr, "kernel_launch: unexpected shapes: n_in %d in0 %d out %d ws %zu (need %zu)\n", n_in, n_in > 0 ? in_sizes[0] : -1, out_size, ws_size, (size_t)WS_END); grid = -1; return; }
        int dev = 0, cus = 0, per_cu = 0;
        if (hipGetDevice(&dev) != hipSuccess || hipDeviceGetAttribute(&cus, hipDeviceAttributeMultiprocessorCount, dev) != hipSuccess) { fprintf(stderr, "kernel_launch: device query failed\n"); grid = -1; return; }
        if (hipFuncSetAttribute((const void*)mk_fwd, hipFuncAttributeMaxDynamicSharedMemorySize, LDS_BYTES) != hipSuccess) { fprintf(stderr, "kernel_launch: hipFuncSetAttribute failed\n"); grid = -1; return; }
        if (hipOccupancyMaxActiveBlocksPerMultiprocessor(&per_cu, (const void*)mk_fwd, NWAVES * 64, LDS_BYTES) != hipSuccess || per_cu < 1) fprintf(stderr, "kernel_launch: occupancy query reports %d blocks per CU\n", per_cu);
        (void)hipGetLastError();
        grid = cus;
    }
    if (grid < 0) return;
    if (hipMemsetAsync((char*)d_ws + WS_CTL, 0, CTL_ZERO_BYTES, stream) != hipSuccess) { fprintf(stderr, "kernel_launch: memset failed\n"); return; }
    Args a{};
    for (int i = 0; i < 31; ++i) a.in[i] = (const float*)d_in[i];
    a.out = (float*)d_out; a.ws = (unsigned char*)d_ws;
    for (int li = 0; li < N_LAUNCHES; ++li) {
        a.ph_lo = (N_LAUNCHES == 1) ? 0 : li; a.ph_hi = (N_LAUNCHES == 1) ? PER_PHASE : li + 1;
        hipLaunchKernelGGL(mk_fwd, dim3(grid), dim3(NWAVES * 64), LDS_BYTES, stream, a);
        const hipError_t le = hipPeekAtLastError();
        if (le != hipSuccess) { fprintf(stderr, "kernel_launch: launch %d failed: %s\n", li, hipGetErrorName(le)); break; }
    }
}
```
